# Optimizing an MI355X kernel written in HIP

```python
import jax, jax.numpy as jnp
from jax import lax
import numpy as np

D_MODEL = 1024
BATCH = 4
SEQ = 4096
DEPTH = 2

PLE_DIM = 256
N_HEADS = 8
HEAD_DIM = 64
ATTN_WIDTH = N_HEADS * HEAD_DIM
CONV_WIDTH = D_MODEL // 2
CONV_K = 3
D_FF = 2816
BLOCK = 256
TOP_K = 3
Q_CHUNK = 64
ROPE_THETA = 10000.0
EPS = 1e-6
IN_COLS = 3 * CONV_WIDTH + 3 * ATTN_WIDTH + 2 * D_MODEL

kernel_name = "hybrid_conv_moba_macaron_ple"


def rmsnorm(x, g):
    xf = x.astype(jnp.float32)
    y = xf * lax.rsqrt(jnp.mean(xf * xf, axis=-1, keepdims=True) + EPS)
    return (y * g.astype(jnp.float32)).astype(x.dtype)


def swiglu(u, w_gate, w_up, w_down):
    return (jax.nn.silu(u @ w_gate) * (u @ w_up)) @ w_down


def rope(x, positions):
    half = HEAD_DIM // 2
    inv_freq = ROPE_THETA ** (-jnp.arange(half, dtype=jnp.float32) / half)
    ang = positions.astype(jnp.float32)[:, :, None] * inv_freq
    cos = jnp.cos(ang)[:, :, None, :]
    sin = jnp.sin(ang)[:, :, None, :]
    xf = x.astype(jnp.float32)
    x1, x2 = xf[..., :half], xf[..., half:]
    out = jnp.concatenate([x1 * cos - x2 * sin, x2 * cos + x1 * sin], axis=-1)
    return out.astype(x.dtype)


def short_conv_mixer(b_gate, c_gate, xc, conv_w):
    u = c_gate * xc
    s = u.shape[1]
    up = jnp.pad(u, ((0, 0), (CONV_K - 1, 0), (0, 0)))
    conv = up[:, 0:s] * conv_w[0]
    for j in range(1, CONV_K):
        conv = conv + up[:, j:j + s] * conv_w[j]
    return b_gate * conv


def moba_attention(q, k, v):
    b, h, s, dh = q.shape
    nb = max(-(-s // BLOCK), TOP_K)
    pad = nb * BLOCK - s
    kp = jnp.pad(k, ((0, 0), (0, 0), (0, pad), (0, 0)))
    vp = jnp.pad(v, ((0, 0), (0, 0), (0, pad), (0, 0)))
    kb = kp.reshape(b, h, nb, BLOCK, dh)
    vb = vp.reshape(b, h, nb, BLOCK, dh)
    kmean = jnp.mean(kb.astype(jnp.float32), axis=3).astype(k.dtype)
    scale = HEAD_DIM ** -0.5
    bi = jnp.arange(b)[:, None, None, None]
    hi = jnp.arange(h)[None, :, None, None]
    n_chunks = s // Q_CHUNK

    def chunk(c):
        start = c * Q_CHUNK
        blk = start // BLOCK
        qc = lax.dynamic_slice_in_dim(q, start, Q_CHUNK, axis=2)
        gate = jnp.einsum('bhqd,bhnd->bhqn', qc, kmean).astype(jnp.float32)
        gate = jnp.where(jnp.arange(nb) < blk, gate, -jnp.inf)
        _, idx = lax.top_k(gate, TOP_K)
        k_sel = kb[bi, hi, idx]
        v_sel = vb[bi, hi, idx]
        s_sel = jnp.einsum('bhqd,bhqjkd->bhqjk', qc, k_sel).astype(jnp.float32) * scale
        slot_ok = jnp.arange(TOP_K) < blk
        s_sel = jnp.where(slot_ok[:, None], s_sel, -jnp.inf).reshape(b, h, Q_CHUNK, TOP_K * BLOCK)
        k_own = lax.dynamic_slice_in_dim(kp, blk * BLOCK, BLOCK, axis=2)
        v_own = lax.dynamic_slice_in_dim(vp, blk * BLOCK, BLOCK, axis=2)
        s_own = jnp.einsum('bhqd,bhkd->bhqk', qc, k_own).astype(jnp.float32) * scale
        qpos = start + jnp.arange(Q_CHUNK)
        kpos = blk * BLOCK + jnp.arange(BLOCK)
        s_own = jnp.where(kpos[None, :] <= qpos[:, None], s_own, -jnp.inf)
        probs = jax.nn.softmax(jnp.concatenate([s_sel, s_own], axis=-1), axis=-1).astype(v.dtype)
        p_sel = probs[..., :TOP_K * BLOCK].reshape(b, h, Q_CHUNK, TOP_K, BLOCK)
        p_own = probs[..., TOP_K * BLOCK:]
        return (jnp.einsum('bhqjk,bhqjkd->bhqd', p_sel, v_sel)
                + jnp.einsum('bhqk,bhkd->bhqd', p_own, v_own))

    outs = lax.map(chunk, jnp.arange(n_chunks))
    return outs.transpose(1, 2, 0, 3, 4).reshape(b, h, s, dh)


def token_mixing(u, positions, w_in, conv_w, w_conv_out, w_attn_out, w_o):
    b, s, _ = u.shape
    proj = u @ w_in
    cuts = [CONV_WIDTH, 2 * CONV_WIDTH, 3 * CONV_WIDTH,
            3 * CONV_WIDTH + ATTN_WIDTH, 3 * CONV_WIDTH + 2 * ATTN_WIDTH,
            3 * CONV_WIDTH + 3 * ATTN_WIDTH, 3 * CONV_WIDTH + 3 * ATTN_WIDTH + D_MODEL]
    b_gate, c_gate, xc, q, k, v, g_conv, g_attn = jnp.split(proj, cuts, axis=-1)
    y_conv = short_conv_mixer(b_gate, c_gate, xc, conv_w) @ w_conv_out
    q = rope(q.reshape(b, s, N_HEADS, HEAD_DIM), positions).transpose(0, 2, 1, 3)
    k = rope(k.reshape(b, s, N_HEADS, HEAD_DIM), positions).transpose(0, 2, 1, 3)
    v = v.reshape(b, s, N_HEADS, HEAD_DIM).transpose(0, 2, 1, 3)
    o = moba_attention(q, k, v).transpose(0, 2, 1, 3).reshape(b, s, ATTN_WIDTH)
    y_attn = o @ w_attn_out
    merged = jax.nn.sigmoid(g_conv) * y_conv + jax.nn.sigmoid(g_attn) * y_attn
    return merged @ w_o


def _w(key, shape, fan_in):
    return jax.random.normal(key, shape, jnp.float32) * (fan_in ** -0.5)


def _gain(key, shape):
    return 1.0 + 0.02 * jax.random.normal(key, shape, jnp.float32)


def setup_inputs(seed: int = 0) -> dict:
    key = jax.random.key(seed)
    ks = jax.random.split(key, 24)
    offsets = jax.random.randint(ks[2], (BATCH, 1), 0, 1024, dtype=jnp.int32)
    positions = (offsets + jnp.arange(SEQ, dtype=jnp.int32)[None, :]).astype(jnp.int32)
    return {
        "x": jax.random.normal(ks[0], (BATCH, SEQ, D_MODEL), jnp.float32),
        "p": jax.random.normal(ks[1], (DEPTH, BATCH, SEQ, PLE_DIM), jnp.float32),
        "positions": positions,
        "w_in": _w(ks[3], (DEPTH, D_MODEL, IN_COLS), D_MODEL),
        "conv_w": _w(ks[4], (DEPTH, CONV_K, CONV_WIDTH), CONV_K),
        "w_conv_out": _w(ks[5], (DEPTH, CONV_WIDTH, D_MODEL), CONV_WIDTH),
        "w_attn_out": _w(ks[6], (DEPTH, ATTN_WIDTH, D_MODEL), ATTN_WIDTH),
        "w_o": _w(ks[7], (DEPTH, D_MODEL, D_MODEL), D_MODEL),
        "ffn1_gate": _w(ks[8], (DEPTH, D_MODEL, D_FF), D_MODEL),
        "ffn1_up": _w(ks[9], (DEPTH, D_MODEL, D_FF), D_MODEL),
        "ffn1_down": _w(ks[10], (DEPTH, D_FF, D_MODEL), D_FF),
        "ffn2_gate": _w(ks[11], (DEPTH, D_MODEL, D_FF), D_MODEL),
        "ffn2_up": _w(ks[12], (DEPTH, D_MODEL, D_FF), D_MODEL),
        "ffn2_down": _w(ks[13], (DEPTH, D_FF, D_MODEL), D_FF),
        "norm_ffn1": _gain(ks[14], (DEPTH, D_MODEL)),
        "norm_mix": _gain(ks[15], (DEPTH, D_MODEL)),
        "norm_ffn2": _gain(ks[16], (DEPTH, D_MODEL)),
        "norm_ple": _gain(ks[17], (DEPTH, D_MODEL)),
        "w_ple_gate": _w(ks[18], (DEPTH, D_MODEL, D_MODEL), D_MODEL),
        "w_ple_proj": _w(ks[19], (DEPTH, PLE_DIM, D_MODEL), PLE_DIM),
        "norm_final": _gain(ks[20], (D_MODEL,)),
    }


def reference(x, p, positions, w_in, conv_w, w_conv_out, w_attn_out, w_o,
              ffn1_gate, ffn1_up, ffn1_down, ffn2_gate, ffn2_up, ffn2_down,
              norm_ffn1, norm_mix, norm_ffn2, norm_ple, w_ple_gate, w_ple_proj,
              norm_final):
    h = x
    for i in range(DEPTH):
        h = h + 0.5 * swiglu(rmsnorm(h, norm_ffn1[i]), ffn1_gate[i], ffn1_up[i], ffn1_down[i])
        h = h + token_mixing(rmsnorm(h, norm_mix[i]), positions, w_in[i], conv_w[i],
                             w_conv_out[i], w_attn_out[i], w_o[i])
        h = h + 0.5 * swiglu(rmsnorm(h, norm_ffn2[i]), ffn2_gate[i], ffn2_up[i], ffn2_down[i])
        h = h + jax.nn.sigmoid(rmsnorm(h, norm_ple[i]) @ w_ple_gate[i]) * (p[i] @ w_ple_proj[i])
    return rmsnorm(h, norm_final)
```

```cpp
#include <hip/hip_runtime.h>
#include <hip/hip_cooperative_groups.h>
#include <cstdio>
#include <cstdint>

#ifndef MK_ONE_LAUNCH
#define MK_ONE_LAUNCH 0
#endif

#define LAS __attribute__((address_space(3)))
#define GAS __attribute__((address_space(1)))
typedef unsigned short bf16_t;
typedef short bf16x8 __attribute__((ext_vector_type(8)));
typedef float f32x4 __attribute__((ext_vector_type(4)));
typedef float f32x2 __attribute__((ext_vector_type(2)));
typedef unsigned u32x4 __attribute__((ext_vector_type(4)));
typedef unsigned u32x2 __attribute__((ext_vector_type(2)));

constexpr int M = 16384, DM = 1024, FF = 2816, NGU = 2 * FF, NIN = 5120, SEQ = 4096, NBATCH = 4, NHEAD = 8, HD = 64, CW = 512, AW = 512, PLED = 256, DEPTH = 2, NBLK = 16;
constexpr float EPS = 1e-6f;
constexpr float LOG2E = 1.4426950408889634f;
constexpr float C2 = 0.125f * LOG2E;

constexpr size_t MiB = 1u << 20;
constexpr size_t WS_CTL = 0, CTL_ZERO_BYTES = 1 * MiB;
constexpr size_t WO_GU1 = 0, WO_D1 = WO_GU1 + (size_t)NGU * DM, WO_IN = WO_D1 + (size_t)DM * FF, WO_C = WO_IN + (size_t)NIN * DM, WO_A = WO_C + (size_t)DM * CW,
                 WO_O = WO_A + (size_t)DM * AW, WO_GU2 = WO_O + (size_t)DM * DM, WO_D2 = WO_GU2 + (size_t)NGU * DM, WO_PG = WO_D2 + (size_t)DM * FF, WO_PP = WO_PG + (size_t)DM * DM,
                 WL_ELEMS = WO_PP + (size_t)DM * PLED;
static_assert(WL_ELEMS == 25952256, "weight block");
constexpr size_t WS_W = 1 * MiB;
constexpr size_t WS_HB = 100 * MiB;
constexpr size_t WS_X = 132 * MiB;
constexpr size_t X_BG = 0, X_U = 16 * MiB, X_Q = 32 * MiB, X_K = 48 * MiB, X_V = 64 * MiB, X_SGC = 80 * MiB, X_SGA = 112 * MiB;
constexpr size_t X_ACT = 0, X_MERGED = 0, X_T2 = 88 * MiB, X_PB = 120 * MiB;
constexpr size_t WS_SSQ0 = 276 * MiB, WS_SSQ1 = WS_SSQ0 + 256 * 1024, WS_KSUM = WS_SSQ1 + 256 * 1024, WS_COS = 277 * MiB, WS_SIN = 279 * MiB, WS_END = 281 * MiB;
static_assert(WS_W + 2 * WL_ELEMS * 2 <= WS_HB, "weights fit");
static_assert((size_t)M * FF * 2 <= 88 * MiB, "ACT fits");

constexpr int RING_BYTES = 131072;
constexpr int LDSCTL_OFF = RING_BYTES, MISC_OFF = LDSCTL_OFF + 320;
constexpr int LDS_BYTES = 147456;
constexpr int NWAVES = 8;

#define LDS_WAIT() asm volatile("s_waitcnt lgkmcnt(0)" ::: "memory")
#define VM_WAIT() asm volatile("s_waitcnt vmcnt(0)" ::: "memory")
#define RLX_AGENT __ATOMIC_RELAXED, __HIP_MEMORY_SCOPE_AGENT

__device__ __forceinline__ unsigned f2bf(float f) { unsigned u = __builtin_bit_cast(unsigned, f); return (u + 0x7fffu + ((u >> 16) & 1u)) >> 16; }
__device__ __forceinline__ unsigned pk2(float lo, float hi) { return f2bf(lo) | (f2bf(hi) << 16); }
__device__ __forceinline__ unsigned cvt_pk_bf16(float lo, float hi) { unsigned r; asm volatile("v_cvt_pk_bf16_f32 %0, %1, %2" : "=v"(r) : "v"(lo), "v"(hi)); return r; }
__device__ __forceinline__ float bf_lo(unsigned w) { return __builtin_bit_cast(float, w << 16); }
__device__ __forceinline__ float bf_hi(unsigned w) { return __builtin_bit_cast(float, w & 0xffff0000u); }
__device__ __forceinline__ float rstd_of(const float* ssq, int r) { const f32x4 s = *(const f32x4*)(ssq + 4 * (size_t)r); return rsqrtf(((s.x + s.y) + (s.z + s.w)) * (1.0f / DM) + EPS); }
__device__ __forceinline__ int tid_now(int wave_s) { int l; asm volatile("v_mbcnt_lo_u32_b32 %0, -1, 0\n\tv_mbcnt_hi_u32_b32 %0, -1, %0" : "=v"(l)); return wave_s * 64 + l; }
template <class T> __device__ __forceinline__ T ldg(const void* base, unsigned boff) { return *(const T*)((const char*)base + boff); }
template <class T> __device__ __forceinline__ void stg(void* base, unsigned boff, T v) { *(T*)((char*)base + boff) = v; }
__device__ __forceinline__ float rstd_at(const float* ssq, int r) { const f32x4 s = ldg<f32x4>(ssq, (unsigned)r * 16u); return __builtin_amdgcn_rsqf(((s.x + s.y) + (s.z + s.w)) * (1.0f / DM) + EPS); }
__device__ __forceinline__ float shx(float v, int mask, int lane) { return __builtin_bit_cast(float, __builtin_amdgcn_ds_bpermute((lane ^ mask) << 2, __builtin_bit_cast(int, v))); }
__device__ __forceinline__ float sigmoidf_(float x) { return __builtin_amdgcn_rcpf(1.0f + __builtin_amdgcn_exp2f(-x * LOG2E)); }

namespace pg8 {
constexpr int BM = 256, BK = 64, HALF = 128, HTB = HALF * BK * 2, STAGE_BYTES = 8 * HTB, NXCD = 8, WGM = 8;
__host__ __device__ __forceinline__ int lds_byte(int r, int c) { const int st = (r >> 4) * 2 + (c >> 5), rr = r & 15, cc = c & 31, ob = rr * 64 + cc * 2; return st * 1024 + (ob ^ (((ob >> 9) & 1) << 5)); }
__host__ __device__ __forceinline__ void stage_rc(int b, int& R, int& C) { const int st = b / 1024, sb = b % 1024, swz = sb ^ (((sb >> 9) & 1) << 5); R = (st >> 1) * 16 + swz / 64; C = (st & 1) * 32 + (swz % 64) / 2; }
__host__ __device__ __forceinline__ int perm32(int rho) { const int n = rho >> 4, i = rho & 15; return 8 * (i >> 2) + 4 * n + (i & 3); }

struct Unit { int pm, pn, seg; };
struct Gemm { const bf16_t* A0; const bf16_t* B0; const bf16_t* A1; const bf16_t* B1; int K; };

struct StaticOrder {
    int nM, nN, nwg, G, c;
    __device__ void init(int M_, int N_, int G_, int c_) { nM = M_ / BM; nN = N_ / BM; nwg = nM * nN; G = G_; c = c_; }
    __device__ bool next(int i, Unit& u) const {
        const long L = (long)i * G + c; if (L >= nwg) return false;
        int wgid = (int)L; { const int q = nwg / NXCD, r = nwg % NXCD, xcd = wgid % NXCD, off = wgid / NXCD; wgid = (xcd < r ? xcd * (q + 1) : r * (q + 1) + (xcd - r) * q) + off; }
        const int nig = WGM * nN, gid = wgid / nig, fm = gid * WGM, gsz = (nM - fm) < WGM ? (nM - fm) : WGM;
        u.pm = fm + ((wgid % nig) % gsz); u.pn = (wgid % nig) / gsz; u.seg = 0; return true;
    }
};
struct TwoSegOrder {
    StaticOrder so;
    __device__ bool next(int i, Unit& u) const { if (i >= 2) return false; const bool ok = so.next(0, u); u.seg = i; return ok; }
};

template <class Epi, class Sched, bool ALIGN_EPI>
__device__ __forceinline__ void gemm_phase(LAS unsigned char* lds, const Gemm g, const Sched& S, const Epi& E, int wave_s) {
    const int tid = tid_now(wave_s), wid = __builtin_amdgcn_readfirstlane(tid >> 6), lane = tid & 63, wr = wid >> 2, wc = wid & 3, fr = lane & 15, fq = lane >> 4;
    const int K = g.K, nt = K / BK;
    unsigned voffA[2], voffB[2];
#pragma unroll
    for (int i = 0; i < 2; ++i) { int R, C; stage_rc(tid * 16 + i * 8192, R, C); const int Rb = Epi::PERM ? ((R & ~31) + perm32(R & 31)) : R;
        voffA[i] = (unsigned)(R * K + C) * 2u; voffB[i] = (unsigned)(Rb * K + C) * 2u; }
    const size_t kstep = (size_t)(BK * 2);
    const size_t hstep = (size_t)HALF * K * 2;
    const size_t tstep = 2 * hstep;
    const unsigned ldsw = (unsigned)wid * 1024u;
    const int aoff = lds_byte(wr * 64 + fr, fq * 8), boff = lds_byte(wc * 32 + fr, fq * 8);
#define PG8_SA(b, h) (((b) * 2 + (h)) * HTB)
#define PG8_SB(b, h) ((4 + (b) * 2 + (h)) * HTB)
#define PG8_STAGE(bufoff, gbase, voff) do { _Pragma("unroll") for (int _i = 0; _i < 2; ++_i) \
        __builtin_amdgcn_global_load_lds((const unsigned*)((const char*)(gbase) + (voff)[_i]), (LAS unsigned*)(lds + (bufoff) + ldsw + _i * 8192), 16, 0, 0); } while (0)
#define PG8_LDA(dst, b, h) do { _Pragma("unroll") for (int m = 0; m < 4; ++m) _Pragma("unroll") for (int k = 0; k < 2; ++k) dst[m][k] = *(const LAS bf16x8*)(lds + PG8_SA(b, h) + aoff + m * 2048 + k * 1024); } while (0)
#define PG8_LDB(dst, b, h) do { _Pragma("unroll") for (int n = 0; n < 2; ++n) _Pragma("unroll") for (int k = 0; k < 2; ++k) dst[n][k] = *(const LAS bf16x8*)(lds + PG8_SB(b, h) + boff + n * 2048 + k * 1024); } while (0)
#define PG8_MMA(ai, bj, At, Bt) do { __builtin_amdgcn_s_setprio(1); _Pragma("unroll") for (int m = 0; m < 4; ++m) _Pragma("unroll") for (int n = 0; n < 2; ++n) _Pragma("unroll") for (int k = 0; k < 2; ++k) \
        acc[ai][bj][m][n] = __builtin_amdgcn_mfma_f32_16x16x32_bf16(Bt[n][k], At[m][k], acc[ai][bj][m][n], 0, 0, 0); __builtin_amdgcn_s_setprio(0); } while (0)
#define PG8_WAIT_V(n) asm volatile("s_waitcnt vmcnt(" #n ")" ::: "memory")
#define PG8_WAIT_L(n) asm volatile("s_waitcnt lgkmcnt(" #n ")" ::: "memory")
#define PG8_BAR __builtin_amdgcn_s_barrier()
#define PG8_SCHED __builtin_amdgcn_sched_barrier(0)
    Unit cur, nxt; int ui = 0;
    if (!S.next(0, cur)) return;
    f32x4 acc[2][2][4][2];
#pragma unroll
    for (int a = 0; a < 2; ++a)
#pragma unroll
        for (int b = 0; b < 2; ++b)
#pragma unroll
            for (int m = 0; m < 4; ++m)
#pragma unroll
                for (int n = 0; n < 2; ++n) acc[a][b][m][n] = (f32x4){0.f, 0.f, 0.f, 0.f};
    bf16x8 At[4][2], B0[2][2], B1[2][2];
    const char* cA = (const char*)(cur.seg ? g.A1 : g.A0) + (size_t)cur.pm * tstep; const char* cB = (const char*)(cur.seg ? g.B1 : g.B0) + (size_t)cur.pn * tstep;
    PG8_STAGE(PG8_SB(0, 0), cB, voffB); PG8_STAGE(PG8_SB(0, 1), cB + hstep, voffB); PG8_STAGE(PG8_SA(0, 0), cA, voffA); PG8_STAGE(PG8_SA(0, 1), cA + hstep, voffA);
    if (wr == 1) PG8_BAR;
    PG8_WAIT_V(2); PG8_BAR;
    PG8_STAGE(PG8_SB(1, 0), cB + kstep, voffB); PG8_STAGE(PG8_SA(1, 0), cA + kstep, voffA); PG8_STAGE(PG8_SB(1, 1), cB + hstep + kstep, voffB);
    PG8_WAIT_V(6); PG8_BAR;
    for (;;) {
        const bool has_next = S.next(ui + 1, nxt);
        const char* nA = has_next ? (const char*)(nxt.seg ? g.A1 : g.A0) + (size_t)nxt.pm * tstep : cA; const char* nB = has_next ? (const char*)(nxt.seg ? g.B1 : g.B0) + (size_t)nxt.pn * tstep : cB;
        for (int t = 0; t < nt; t += 2) {
            const bool last = (t == nt - 2);
            const char* a1 = cA + (size_t)(t + 1) * kstep;
            const char* a2 = last ? nA : cA + (size_t)(t + 2) * kstep; const char* b2 = last ? nB : cB + (size_t)(t + 2) * kstep;
            const char* a3 = a2 + kstep; const char* b3 = b2 + kstep;
            PG8_LDB(B0, 0, 0); PG8_LDB(B1, 0, 1); PG8_SCHED; PG8_LDA(At, 0, 0); PG8_STAGE(PG8_SA(1, 1), a1 + hstep, voffA);
            PG8_WAIT_V(8); PG8_WAIT_L(0); PG8_BAR; PG8_MMA(0, 0, At, B0); PG8_MMA(0, 1, At, B1); PG8_BAR; PG8_SCHED;
            PG8_LDA(At, 0, 1); PG8_STAGE(PG8_SB(0, 0), b2, voffB); PG8_STAGE(PG8_SB(0, 1), b2 + hstep, voffB); PG8_STAGE(PG8_SA(0, 0), a2, voffA);
            PG8_WAIT_V(8); PG8_WAIT_L(0); PG8_BAR; PG8_MMA(1, 0, At, B0); PG8_MMA(1, 1, At, B1); PG8_BAR; PG8_SCHED;
            PG8_LDB(B0, 1, 0); PG8_LDB(B1, 1, 1); PG8_SCHED; PG8_LDA(At, 1, 0); PG8_STAGE(PG8_SA(0, 1), a2 + hstep, voffA);
            PG8_WAIT_V(8); PG8_WAIT_L(0); PG8_BAR; PG8_MMA(0, 0, At, B0); PG8_MMA(0, 1, At, B1); PG8_BAR; PG8_SCHED;
            PG8_LDA(At, 1, 1); PG8_STAGE(PG8_SB(1, 0), b3, voffB); PG8_STAGE(PG8_SB(1, 1), b3 + hstep, voffB); PG8_STAGE(PG8_SA(1, 0), a3, voffA);
            PG8_WAIT_V(8); PG8_WAIT_L(0); PG8_BAR; PG8_MMA(1, 0, At, B0); PG8_MMA(1, 1, At, B1); PG8_BAR; PG8_SCHED;
        }
        if constexpr (ALIGN_EPI) { if (wr == 0) PG8_BAR; }
        if constexpr (!Epi::AFTER_DRAIN) { const int l2 = tid_now(wave_s) & 63;
            E(acc, cur, wr, wc, l2 & 15, l2 >> 4); }
        if (!has_next) break;
        if (!(Epi::CARRY && nxt.seg != 0)) {
#pragma unroll
        for (int a = 0; a < 2; ++a)
#pragma unroll
            for (int b = 0; b < 2; ++b)
#pragma unroll
                for (int m = 0; m < 4; ++m)
#pragma unroll
                    for (int n = 0; n < 2; ++n) acc[a][b][m][n] = (f32x4){0.f, 0.f, 0.f, 0.f};
        }
        cur = nxt; cA = nA; cB = nB; ++ui;
        if constexpr (ALIGN_EPI) { if (wr == 1) PG8_BAR; }
    }
    PG8_WAIT_V(0);
    if constexpr (!ALIGN_EPI) { if (wr == 0) PG8_BAR; }
    PG8_BAR;
    if constexpr (Epi::AFTER_DRAIN) { const int l2 = tid_now(wave_s) & 63; E.fused(acc, cur, wr, wc, l2 & 15, l2 >> 4, lds, wid, l2); }
#undef PG8_SA
#undef PG8_SB
#undef PG8_STAGE
#undef PG8_LDA
#undef PG8_LDB
#undef PG8_MMA
#undef PG8_WAIT_V
#undef PG8_WAIT_L
#undef PG8_BAR
#undef PG8_SCHED
}

typedef f32x4 (&AccRef)[2][2][4][2];
#define ROWGROUP_BEGIN(r, expr) int r = (expr); asm volatile("" : "+v"(r) :: "memory")
__device__ __forceinline__ u32x4 pack8(const f32x4 a, const f32x4 b) { u32x4 w; w.x = cvt_pk_bf16(a[0], a[1]); w.y = cvt_pk_bf16(a[2], a[3]); w.z = cvt_pk_bf16(b[0], b[1]); w.w = cvt_pk_bf16(b[2], b[3]); return w; }
__device__ __forceinline__ void unpack8(const u32x4 t, f32x4& a, f32x4& b) { a = (f32x4){bf_lo(t.x), bf_hi(t.x), bf_lo(t.y), bf_hi(t.y)}; b = (f32x4){bf_lo(t.z), bf_hi(t.z), bf_lo(t.w), bf_hi(t.w)}; }

struct EpiSwiglu {
    static constexpr bool PERM = true, AFTER_DRAIN = false, CARRY = false;
    bf16_t* ACT; const float* ssq;
    __device__ __forceinline__ void operator()(AccRef acc, const Unit& u, int wr, int wc, int fr, int fq) const {
        const int row0 = u.pm * BM + wr * 64 + fr, col0 = u.pn * 128 + wc * 32 + 8 * fq;
#pragma unroll
        for (int ai = 0; ai < 2; ++ai)
#pragma unroll
            for (int m = 0; m < 4; ++m) { ROWGROUP_BEGIN(r, row0 + ai * HALF + m * 16); const float rs = rstd_at(ssq, r);
                f32x4 o0, o1;
#pragma unroll
                for (int i = 0; i < 4; ++i) { const float g0 = acc[ai][0][m][0][i] * rs, u0 = acc[ai][1][m][0][i] * rs, g1 = acc[ai][0][m][1][i] * rs, u1 = acc[ai][1][m][1][i] * rs;
                    o0[i] = g0 * u0 * sigmoidf_(g0); o1[i] = g1 * u1 * sigmoidf_(g1); }
                stg<u32x4>(ACT, (unsigned)(r * FF + col0) * 2u, pack8(o0, o1)); }
    }
};

struct EpiPlain {
    static constexpr bool PERM = true, AFTER_DRAIN = false, CARRY = false;
    bf16_t* O; int ldc;
    __device__ __forceinline__ void operator()(AccRef acc, const Unit& u, int wr, int wc, int fr, int fq) const {
        const int row0 = u.pm * BM + wr * 64 + fr, col0 = u.pn * BM + wc * 32 + 8 * fq;
#pragma unroll
        for (int ai = 0; ai < 2; ++ai)
#pragma unroll
            for (int m = 0; m < 4; ++m) { ROWGROUP_BEGIN(r, row0 + ai * HALF + m * 16);
#pragma unroll
                for (int bj = 0; bj < 2; ++bj) stg<u32x4>(O, (unsigned)(r * ldc + col0 + bj * HALF) * 2u, pack8(acc[ai][bj][m][0], acc[ai][bj][m][1])); }
    }
};

struct EpiWin {
    static constexpr bool PERM = true, AFTER_DRAIN = false, CARRY = false;
    unsigned char* ws; const float* ssq;
    __device__ __forceinline__ void operator()(AccRef acc, const Unit& u, int wr, int wc, int fr, int fq) const {
        const int pn = u.pn, row0 = u.pm * BM + wr * 64 + fr, cw = wc * 32 + 8 * fq;
        unsigned char* X = ws + WS_X;
        if (pn >= 2 && pn < 6) {
            const int col0 = (pn - 2) * 128 + cw;
#pragma unroll
            for (int ai = 0; ai < 2; ++ai)
#pragma unroll
                for (int m = 0; m < 4; ++m) { ROWGROUP_BEGIN(r, row0 + ai * HALF + m * 16); const float rs = rstd_at(ssq, r), rs2 = rs * rs;
                    stg<u32x4>(X + X_U, (unsigned)(r * CW + col0) * 2u, pack8(acc[ai][0][m][0] * acc[ai][1][m][0] * rs2, acc[ai][0][m][1] * acc[ai][1][m][1] * rs2)); }
        } else if (pn >= 6 && pn < 10) {
            const bool isk = pn >= 8; const int head = ((pn - 6) & 1) * 4 + wc, dd0 = 8 * fq; unsigned char* dst = X + (isk ? X_K : X_Q); const float osc = isk ? 1.0f : C2;
            f32x4 cs[2][2];
#pragma unroll
            for (int a = 0; a < 2; ++a)
#pragma unroll
                for (int b = 0; b < 2; ++b) cs[a][b] = (f32x4){0.f, 0.f, 0.f, 0.f};
#pragma unroll
            for (int ai = 0; ai < 2; ++ai)
#pragma unroll
                for (int m = 0; m < 4; ++m) { ROWGROUP_BEGIN(r, row0 + ai * HALF + m * 16); const float rs = rstd_at(ssq, r);
                    f32x4 y1[2], y2[2];
#pragma unroll
                    for (int n = 0; n < 2; ++n) { const f32x4 c4 = ldg<f32x4>(ws + WS_COS, (unsigned)(r * 32 + dd0 + 4 * n) * 4u), s4 = ldg<f32x4>(ws + WS_SIN, (unsigned)(r * 32 + dd0 + 4 * n) * 4u);
                        const f32x4 x1 = acc[ai][0][m][n] * rs, x2 = acc[ai][1][m][n] * rs;
                        y1[n] = x1 * c4 - x2 * s4; y2[n] = x2 * c4 + x1 * s4; cs[0][n] += y1[n]; cs[1][n] += y2[n]; }
                    stg<u32x4>(dst, (unsigned)(r * AW + head * 64 + dd0) * 2u, pack8(y1[0] * osc, y1[1] * osc));
                    stg<u32x4>(dst, (unsigned)(r * AW + head * 64 + 32 + dd0) * 2u, pack8(y2[0] * osc, y2[1] * osc));
                    asm volatile("" : "+v"(cs[0][0]), "+v"(cs[0][1]), "+v"(cs[1][0]), "+v"(cs[1][1])); }
            if (isk) {
#pragma unroll
                for (int b = 0; b < 2; ++b)
#pragma unroll
                    for (int n = 0; n < 2; ++n)
#pragma unroll
                        for (int i = 0; i < 4; ++i) { const int ln = fq * 16 + fr; float v = cs[b][n][i]; v += shx(v, 1, ln); v += shx(v, 2, ln); v += shx(v, 4, ln); v += shx(v, 8, ln); cs[b][n][i] = v; }
                if (fr == 0) {
#pragma unroll
                    for (int b = 0; b < 2; ++b)
#pragma unroll
                        for (int n = 0; n < 2; ++n) stg<f32x4>(ws + WS_KSUM, (unsigned)((u.pm * 2 + wr) * 512 + head * 64 + dd0 + 32 * b + 4 * n) * 4u, cs[b][n]); }
            }
        } else {
            const bool gate = pn >= 12; unsigned char* dst; int ldc, colt;
            if (pn < 2) { dst = X + X_BG; ldc = CW; colt = pn * 256; } else if (pn < 12) { dst = X + X_V; ldc = AW; colt = (pn - 10) * 256; }
            else if (pn < 16) { dst = X + X_SGC; ldc = DM; colt = (pn - 12) * 256; } else { dst = X + X_SGA; ldc = DM; colt = (pn - 16) * 256; }
#pragma unroll
            for (int ai = 0; ai < 2; ++ai)
#pragma unroll
                for (int m = 0; m < 4; ++m) { ROWGROUP_BEGIN(r, row0 + ai * HALF + m * 16); const float rs = rstd_at(ssq, r);
#pragma unroll
                    for (int bj = 0; bj < 2; ++bj) { f32x4 v0 = acc[ai][bj][m][0] * rs, v1 = acc[ai][bj][m][1] * rs;
                        if (gate) {
#pragma unroll
                            for (int i = 0; i < 4; ++i) { v0[i] = sigmoidf_(v0[i]); v1[i] = sigmoidf_(v1[i]); } }
                        stg<u32x4>(dst, (unsigned)(r * ldc + colt + bj * HALF + cw) * 2u, pack8(v0, v1)); } }
        }
    }
};

struct EpiMerge {
    static constexpr bool PERM = true, AFTER_DRAIN = false, CARRY = true;
    const bf16_t *SGC, *SGA; bf16_t* MG;
    __device__ __forceinline__ void operator()(AccRef acc, const Unit& u, int wr, int wc, int fr, int fq) const {
        const int row0 = u.pm * BM + wr * 64 + fr, col0 = u.pn * BM + wc * 32 + 8 * fq;
#pragma unroll
        for (int ai = 0; ai < 2; ++ai)
#pragma unroll
            for (int m = 0; m < 4; ++m) { ROWGROUP_BEGIN(r, row0 + ai * HALF + m * 16);
#pragma unroll
                for (int bj = 0; bj < 2; ++bj) { const unsigned off = (unsigned)(r * DM + col0 + bj * HALF) * 2u;
                    f32x4 sa0, sa1; unpack8(ldg<u32x4>(SGA, off), sa0, sa1);
#pragma unroll
                    for (int i = 0; i < 4; ++i) { sa0[i] = fmaxf(sa0[i], 1e-30f); sa1[i] = fmaxf(sa1[i], 1e-30f); }
                    if (u.seg == 0) { f32x4 sc0, sc1; unpack8(ldg<u32x4>(SGC, off), sc0, sc1);
#pragma unroll
                        for (int i = 0; i < 4; ++i) { acc[ai][bj][m][0][i] *= sc0[i] / sa0[i]; acc[ai][bj][m][1][i] *= sc1[i] / sa1[i]; }
                    } else stg<u32x4>(MG, off, pack8(acc[ai][bj][m][0] * sa0, acc[ai][bj][m][1] * sa1)); } }
    }
};

template <int MODE> struct EpiRes {
    static constexpr bool PERM = true, AFTER_DRAIN = true, CARRY = false;
    const float* hin; float* hout; bf16_t* HB; float* ssq_out; float scale; const float* ssq_in; const bf16_t* T2;
    __device__ __forceinline__ void fused(AccRef acc, const Unit& u, int wr, int wc, int fr, int fq, LAS unsigned char* lds, int wid, int lane) const {
        LAS float* P = (LAS float*)lds;
        const int row0 = u.pm * BM + wr * 64 + fr, col0 = u.pn * BM + wc * 32 + 8 * fq;
#pragma unroll
        for (int ai = 0; ai < 2; ++ai)
#pragma unroll
            for (int m = 0; m < 4; ++m) { ROWGROUP_BEGIN(r, row0 + ai * HALF + m * 16); float q = 0.f;
                float rs = 1.f; if (MODE == 1) rs = rstd_at(ssq_in, r);
#pragma unroll
                for (int bj = 0; bj < 2; ++bj) { const unsigned e = (unsigned)(r * DM + col0 + bj * HALF);
                    const f32x4 h0 = ldg<f32x4>(hin, e * 4u), h1 = ldg<f32x4>(hin, e * 4u + 16u);
                    f32x4 y0, y1;
                    if (MODE == 0) { y0 = h0 + acc[ai][bj][m][0] * scale; y1 = h1 + acc[ai][bj][m][1] * scale; }
                    else { f32x4 t0, t1; unpack8(ldg<u32x4>(T2, e * 2u), t0, t1);
#pragma unroll
                        for (int i = 0; i < 4; ++i) { y0[i] = h0[i] + sigmoidf_(acc[ai][bj][m][0][i] * rs) * t0[i]; y1[i] = h1[i] + sigmoidf_(acc[ai][bj][m][1][i] * rs) * t1[i]; } }
                    stg<f32x4>(hout, e * 4u, y0); stg<f32x4>(hout, e * 4u + 16u, y1);
                    stg<u32x4>(HB, e * 2u, pack8(y0, y1));
                    q += (y0[0] * y0[0] + y0[1] * y0[1]) + (y0[2] * y0[2] + y0[3] * y0[3]) + (y1[0] * y1[0] + y1[1] * y1[1]) + (y1[2] * y1[2] + y1[3] * y1[3]); }
                q += shx(q, 16, lane); q += shx(q, 32, lane);
                if (fq == 0) P[(ai * HALF + wr * 64 + m * 16 + fr) * 4 + wc] = q; }
        asm volatile("s_waitcnt lgkmcnt(0)" ::: "memory"); __builtin_amdgcn_s_barrier(); asm volatile("" ::: "memory");
        const int t = wid * 64 + lane;
        if (t < 256) { const f32x4 p = *(const LAS f32x4*)(P + 4 * t); ssq_out[(size_t)(u.pm * BM + t) * 4 + u.pn] = (p.x + p.y) + (p.z + p.w); }
        asm volatile("s_waitcnt lgkmcnt(0)" ::: "memory"); __builtin_amdgcn_s_barrier(); asm volatile("" ::: "memory");
    }
};
}

__device__ __forceinline__ float wave_sum(float v, int lane) {
#pragma unroll
    for (int o = 1; o < 64; o <<= 1) v += shx(v, o, lane);
    return v;
}
__device__ __forceinline__ void transpose_item(const float* W, int Ksrc, int Nsrc, const float* gain, bf16_t* WT, int k0, int n0, int drow0, LAS float* scr, int lane) {
#pragma unroll 8
    for (int i = 0; i < 32; ++i) { const int kk = 2 * i + (lane >> 5); float v = W[(size_t)(k0 + kk) * Nsrc + n0 + (lane & 31)]; if (gain) v *= gain[k0 + kk]; scr[kk * 33 + (lane & 31)] = v; }
    LDS_WAIT(); asm volatile("" ::: "memory");
    const int c = lane & 7;
#pragma unroll
    for (int j = 0; j < 4; ++j) { const int n = (lane >> 3) + 8 * j; const LAS float* s = scr + (8 * c) * 33 + n;
        u32x4 o; o.x = pk2(s[0 * 33], s[1 * 33]); o.y = pk2(s[2 * 33], s[3 * 33]); o.z = pk2(s[4 * 33], s[5 * 33]); o.w = pk2(s[6 * 33], s[7 * 33]);
        *(u32x4*)(WT + (size_t)(drow0 + n) * Ksrc + k0 + 8 * c) = o; }
    LDS_WAIT(); asm volatile("" ::: "memory");
}
__device__ __forceinline__ int win_drow(int c) {
    if (c < 512) return c;
    if (c < 1024) { const int ch = c - 512; return 512 + (ch >> 7) * 256 + (ch & 127); }
    if (c < 1536) { const int ch = c - 1024; return 512 + (ch >> 7) * 256 + 128 + (ch & 127); }
    if (c < 2560) { const int base = c < 2048 ? 1536 : 2048; const int cq = c - base, head = cq >> 6, half = (cq >> 5) & 1; return base + (head >> 2) * 256 + half * 128 + (head & 3) * 32; }
    return c;
}
__device__ __forceinline__ int gu_drow(int c, int isup) { return (c >> 7) * 256 + isup * 128 + (c & 127); }

struct Args { const float* in[21]; float* out; unsigned char* ws; int ph_lo, ph_hi; };

constexpr int TBL_OFF = MISC_OFF + 128;
__device__ __forceinline__ const float* in_ptr(LAS unsigned char* lds, int k) {
    const LAS unsigned* t = (const LAS unsigned*)(lds + TBL_OFF) + 2 * k; unsigned lo = t[0], hi = t[1];
    lo = __builtin_amdgcn_readfirstlane(lo); hi = __builtin_amdgcn_readfirstlane(hi);
    return (const float*)(GAS const float*)(((unsigned long long)hi << 32) | lo);
}
__device__ __forceinline__ unsigned char* launder(unsigned char* p) { size_t z = 0; asm volatile("" : "+s"(z)); return p + z; }

constexpr int I_GU = 16 * 88, I_D = 44 * 32, I_IN = 16 * 160, I_C = 8 * 32, I_O = 16 * 32, I_PP = 4 * 32;
constexpr int ITEMS_L = 6 * I_GU + I_IN + 2 * I_C + 2 * I_O + I_PP;
static_assert(I_GU == I_D && ITEMS_L == 12672, "item counts");

__device__ __forceinline__ void p0_weights(LAS unsigned char* lds, bf16_t* Wb, LAS float* scr, int gw, int NGW, int lane) {
    for (int gi = gw; gi < 2 * ITEMS_L; gi += NGW) {
        const int L = gi >= ITEMS_L ? 1 : 0; int r = gi - L * ITEMS_L; bf16_t* WL = Wb + (size_t)L * WL_ELEMS;
        if (r < 4 * I_GU) { const int which = r / I_GU; r -= which * I_GU; const int kb = r / 88, nb = r % 88; const int ffn = which >> 1, isup = which & 1;
            const float* src = in_ptr(lds, (ffn ? 11 : 8) + isup) + (size_t)L * DM * FF; const float* gn = in_ptr(lds, ffn ? 16 : 14) + L * DM;
            transpose_item(src, DM, FF, gn, WL + (ffn ? WO_GU2 : WO_GU1), 64 * kb, 32 * nb, gu_drow(32 * nb, isup), scr, lane); continue; }
        r -= 4 * I_GU;
        if (r < 2 * I_D) { const int ffn = r / I_D; r -= ffn * I_D; const int kb = r / 32, nb = r % 32;
            transpose_item(in_ptr(lds, ffn ? 13 : 10) + (size_t)L * FF * DM, FF, DM, nullptr, WL + (ffn ? WO_D2 : WO_D1), 64 * kb, 32 * nb, 32 * nb, scr, lane); continue; }
        r -= 2 * I_D;
        if (r < I_IN) { const int kb = r / 160, nb = r % 160;
            transpose_item(in_ptr(lds, 3) + (size_t)L * DM * NIN, DM, NIN, in_ptr(lds, 15) + L * DM, WL + WO_IN, 64 * kb, 32 * nb, win_drow(32 * nb), scr, lane); continue; }
        r -= I_IN;
        if (r < 2 * I_C) { const int which = r / I_C; r -= which * I_C; const int kb = r / 32, nb = r % 32;
            transpose_item(in_ptr(lds, 5 + which) + (size_t)L * CW * DM, CW, DM, nullptr, WL + (which ? WO_A : WO_C), 64 * kb, 32 * nb, 32 * nb, scr, lane); continue; }
        r -= 2 * I_C;
        if (r < 2 * I_O) { const int which = r / I_O; r -= which * I_O; const int kb = r / 32, nb = r % 32;
            const float* gn = which ? in_ptr(lds, 17) + L * DM : nullptr;
            transpose_item(in_ptr(lds, which ? 18 : 7) + (size_t)L * DM * DM, DM, DM, gn, WL + (which ? WO_PG : WO_O), 64 * kb, 32 * nb, 32 * nb, scr, lane); continue; }
        r -= 2 * I_O;
        { const int kb = r / 32, nb = r % 32;
            transpose_item(in_ptr(lds, 19) + (size_t)L * PLED * DM, PLED, DM, nullptr, WL + WO_PP, 64 * kb, 32 * nb, 32 * nb, scr, lane); }
    }
}
__device__ __forceinline__ void p0_rows(const float* x, const int* pos, bf16_t* HB, float* ssq0, float* rcos, float* rsin, int gw, int NGW, int lane) {
    for (int m = gw; m < M; m += NGW) {
        const f32x4* xr = (const f32x4*)(x + (size_t)m * DM) + lane; f32x4 v[4]; float s = 0.f;
#pragma unroll
        for (int j = 0; j < 4; ++j) { v[j] = xr[64 * j]; s += (v[j].x * v[j].x + v[j].y * v[j].y) + (v[j].z * v[j].z + v[j].w * v[j].w); }
        s = wave_sum(s, lane);
        u32x2* o8 = (u32x2*)(HB + (size_t)m * DM) + lane;
#pragma unroll
        for (int j = 0; j < 4; ++j) { u32x2 w; w.x = pk2(v[j].x, v[j].y); w.y = pk2(v[j].z, v[j].w); o8[64 * j] = w; }
        if (lane == 0) *(f32x4*)(ssq0 + 4 * (size_t)m) = (f32x4){s, 0.f, 0.f, 0.f};
        if (lane < 32) { const float p = (float)pos[m]; const float invf = exp2f(-(float)lane * (13.287712379549449f / 32.0f)); const float ang = p * invf; float sn, cs; sincosf(ang, &sn, &cs);
            rcos[(size_t)m * 32 + lane] = cs; rsin[(size_t)m * 32 + lane] = sn; }
    }
}
__device__ __forceinline__ void pb_convert(const float* p, bf16_t* PB, int gw, int NGW, int lane) {
    for (int m = gw; m < M; m += NGW) { const f32x4 v = *((const f32x4*)(p + (size_t)m * PLED) + lane); u32x2 w; w.x = pk2(v.x, v.y); w.y = pk2(v.z, v.w); *((u32x2*)(PB + (size_t)m * PLED) + lane) = w; }
}
__device__ __forceinline__ void convmix(const bf16_t* BG, const bf16_t* U, const float* cwt, bf16_t* CM, int gt, int NGT) {
    for (int e = gt; e < M * (CW / 8); e += NGT) { const int r = e >> 6, c8 = (e & 63) * 8, s = r & (SEQ - 1);
        const u32x4 b = *(const u32x4*)(BG + (size_t)r * CW + c8), u0 = *(const u32x4*)(U + (size_t)r * CW + c8);
        u32x4 u1 = (u32x4){0u, 0u, 0u, 0u}, u2 = (u32x4){0u, 0u, 0u, 0u};
        if (s >= 1) u1 = *(const u32x4*)(U + (size_t)(r - 1) * CW + c8);
        if (s >= 2) u2 = *(const u32x4*)(U + (size_t)(r - 2) * CW + c8);
        float o[8];
#pragma unroll
        for (int j = 0; j < 4; ++j) { const unsigned bw = b[j], w0 = u0[j], w1 = u1[j], w2 = u2[j]; const int c = c8 + 2 * j;
            o[2 * j] = bf_lo(bw) * (cwt[c] * bf_lo(w2) + cwt[CW + c] * bf_lo(w1) + cwt[2 * CW + c] * bf_lo(w0));
            o[2 * j + 1] = bf_hi(bw) * (cwt[c + 1] * bf_hi(w2) + cwt[CW + c + 1] * bf_hi(w1) + cwt[2 * CW + c + 1] * bf_hi(w0)); }
        u32x4 w; w.x = pk2(o[0], o[1]); w.y = pk2(o[2], o[3]); w.z = pk2(o[4], o[5]); w.w = pk2(o[6], o[7]);
        *(u32x4*)(CM + (size_t)r * CW + c8) = w; }
}
__device__ __forceinline__ void final_norm(float* h, const float* ssq, const float* g, int gw, int NGW, int lane) {
    for (int m = gw; m < M; m += NGW) { const float rs = rstd_of(ssq, m); f32x4* hr = (f32x4*)(h + (size_t)m * DM) + lane; const f32x4* gr = (const f32x4*)g + lane;
#pragma unroll
        for (int j = 0; j < 4; ++j) { const f32x4 v = hr[64 * j], gg = gr[64 * j]; hr[64 * j] = v * rs * gg; } }
}

__device__ __forceinline__ void attn_simple_item(int it, const bf16_t* Q, const bf16_t* Kb, const bf16_t* Vb, bf16_t* O, const float* KSUM, LAS unsigned char* wl, int lane) {
    const int b = it >> 9, h = (it >> 6) & 7, qc = it & 63, blk = qc >> 2;
    const int s = qc * 64 + lane; const size_t row = (size_t)b * SEQ + s;
    float q[64];
    { const bf16_t* qp = Q + row * AW + h * 64;
#pragma unroll
      for (int j = 0; j < 8; ++j) { const u32x4 v = *(const u32x4*)(qp + 8 * j); q[8 * j] = bf_lo(v.x); q[8 * j + 1] = bf_hi(v.x); q[8 * j + 2] = bf_lo(v.y); q[8 * j + 3] = bf_hi(v.y); q[8 * j + 4] = bf_lo(v.z); q[8 * j + 5] = bf_hi(v.z); q[8 * j + 6] = bf_lo(v.w); q[8 * j + 7] = bf_hi(v.w); } }
    unsigned sel;
    if (blk <= 3) sel = (1u << blk) - 1u;
    else { float v1 = -INFINITY, v2 = -INFINITY, v3 = -INFINITY; int i1 = 31, i2 = 31, i3 = 31;
        for (int n = 0; n < blk; ++n) { const float* k0 = KSUM + ((size_t)(b * NBLK + n) * 2) * 512 + h * 64; float sc = 0.f;
#pragma unroll
            for (int d = 0; d < 64; d += 4) { const f32x4 a = *(const f32x4*)(k0 + d), c = *(const f32x4*)(k0 + 512 + d);
                sc += q[d] * (a.x + c.x) + q[d + 1] * (a.y + c.y) + q[d + 2] * (a.z + c.z) + q[d + 3] * (a.w + c.w); }
            if (sc > v1) { v3 = v2; i3 = i2; v2 = v1; i2 = i1; v1 = sc; i1 = n; }
            else if (sc > v2) { v3 = v2; i3 = i2; v2 = sc; i2 = n; }
            else if (sc > v3) { v3 = sc; i3 = n; } }
        sel = (1u << i1) | (1u << i2) | (1u << i3); }
    float mx = -INFINITY, l = 0.f; float o[64];
#pragma unroll
    for (int d = 0; d < 64; ++d) o[d] = 0.f;
    for (int bi = 0; bi <= blk; ++bi) { const int n = (bi == 0) ? blk : bi - 1; const bool own = (bi == 0); const bool lane_sel = own || ((sel >> n) & 1u);
        if (!__any(lane_sel)) continue;
        for (int t4 = 0; t4 < 4; ++t4) { const int key0 = n * 256 + t4 * 64;
            if (own && key0 > qc * 64 + 63) break;
            const bf16_t* kp = Kb + ((size_t)b * SEQ + key0) * AW + h * 64; const bf16_t* vp = Vb + ((size_t)b * SEQ + key0) * AW + h * 64;
#pragma unroll
            for (int j = 0; j < 8; ++j) { const int ri = (lane >> 3) + 8 * j, ch = lane & 7;
                const u32x4 kv = *(const u32x4*)(kp + (size_t)ri * AW + ch * 8), vv = *(const u32x4*)(vp + (size_t)ri * AW + ch * 8);
                *(LAS u32x4*)(wl + ri * 128 + ch * 16) = kv; *(LAS u32x4*)(wl + 8192 + ri * 128 + ch * 16) = vv; }
            for (int j = 0; j < 64; ++j) { float sc = 0.f;
#pragma unroll
                for (int c = 0; c < 8; ++c) { const u32x4 kk = *(const LAS u32x4*)(wl + j * 128 + c * 16);
                    sc += q[8 * c] * bf_lo(kk.x) + q[8 * c + 1] * bf_hi(kk.x) + q[8 * c + 2] * bf_lo(kk.y) + q[8 * c + 3] * bf_hi(kk.y) + q[8 * c + 4] * bf_lo(kk.z) + q[8 * c + 5] * bf_hi(kk.z) + q[8 * c + 6] * bf_lo(kk.w) + q[8 * c + 7] * bf_hi(kk.w); }
                const bool valid = own ? (key0 + j <= s) : lane_sel;
                sc = valid ? sc : -INFINITY;
                const float mn = fmaxf(mx, sc); const float alpha = __builtin_amdgcn_exp2f(mx - mn), p = __builtin_amdgcn_exp2f(sc - mn);
                l = l * alpha + p; mx = mn;
#pragma unroll
                for (int c = 0; c < 8; ++c) { const u32x4 vv = *(const LAS u32x4*)(wl + 8192 + j * 128 + c * 16);
                    o[8 * c] = o[8 * c] * alpha + p * bf_lo(vv.x); o[8 * c + 1] = o[8 * c + 1] * alpha + p * bf_hi(vv.x); o[8 * c + 2] = o[8 * c + 2] * alpha + p * bf_lo(vv.y); o[8 * c + 3] = o[8 * c + 3] * alpha + p * bf_hi(vv.y);
                    o[8 * c + 4] = o[8 * c + 4] * alpha + p * bf_lo(vv.z); o[8 * c + 5] = o[8 * c + 5] * alpha + p * bf_hi(vv.z); o[8 * c + 6] = o[8 * c + 6] * alpha + p * bf_lo(vv.w); o[8 * c + 7] = o[8 * c + 7] * alpha + p * bf_hi(vv.w); }
            }
        }
    }
    const float inv = 1.0f / l; bf16_t* op = O + row * AW + h * 64;
#pragma unroll
    for (int j = 0; j < 8; ++j) { u32x4 w; w.x = pk2(o[8 * j] * inv, o[8 * j + 1] * inv); w.y = pk2(o[8 * j + 2] * inv, o[8 * j + 3] * inv); w.z = pk2(o[8 * j + 4] * inv, o[8 * j + 5] * inv); w.w = pk2(o[8 * j + 6] * inv, o[8 * j + 7] * inv);
        *(u32x4*)(op + 8 * j) = w; }
}

constexpr int NPHASE = 20;
#ifndef KMASK
#define KMASK 0x3FF
#endif
#define KIND(j) ((KMASK >> (j)) & 1)
__global__ void __launch_bounds__(NWAVES * 64, 2) skel_fwd(Args args) {
    extern __shared__ __attribute__((aligned(16))) unsigned char lds_raw[];
    LAS unsigned char* lds = (LAS unsigned char*)lds_raw;
    const int wave_s = __builtin_amdgcn_readfirstlane(threadIdx.x >> 6);
    {
        const int t0 = threadIdx.x;
        for (int u = t0; u < (LDS_BYTES - LDSCTL_OFF) / 4; u += NWAVES * 64) ((LAS unsigned*)(lds + LDSCTL_OFF))[u] = 0u;
        __syncthreads();
        if (t0 == 0) { LAS unsigned long long* t = (LAS unsigned long long*)(lds + TBL_OFF);
#pragma unroll
            for (int i = 0; i < 21; ++i) t[i] = (unsigned long long)args.in[i]; }
        __syncthreads();
    }
    for (int ph = args.ph_lo; ph < args.ph_hi; ++ph) {
        unsigned char* ws = launder(args.ws);
        int bx_ = blockIdx.x, G_ = gridDim.x; asm volatile("" : "+s"(bx_), "+s"(G_));
        const int G = G_, bx = bx_, vcu = (G % 8 == 0) ? (bx % 8) * (G / 8) + bx / 8 : bx, NGW = G * NWAVES;
        const int wave = wave_s, gw = vcu * NWAVES + wave;
#define TID_LANE const int tid = tid_now(wave_s), lane = tid & 63
        const int L = (ph - 1) / 9, j = (ph == 0) ? -1 : (ph == NPHASE - 1) ? 9 : (ph - 1) % 9;
        bf16_t* HB = (bf16_t*)(ws + WS_HB); unsigned char* X = ws + WS_X;
        const bf16_t* WL = (const bf16_t*)(ws + WS_W) + (size_t)L * WL_ELEMS;
        float *ssq0 = (float*)(ws + WS_SSQ0), *ssq1 = (float*)(ws + WS_SSQ1);
        if (KIND(0) && j == -1) { TID_LANE;
            p0_weights(lds, (bf16_t*)(ws + WS_W), (LAS float*)(lds + wave * 16384), gw, NGW, lane);
            p0_rows(in_ptr(lds, 0), (const int*)in_ptr(lds, 2), HB, ssq0, (float*)(ws + WS_COS), (float*)(ws + WS_SIN), gw, NGW, lane);
        } else if (KIND(1) && (j == 0 || j == 6)) {
            pg8::Gemm g{HB, WL + (j ? WO_GU2 : WO_GU1), nullptr, nullptr, DM}; pg8::StaticOrder S; S.init(M, NGU, G, bx);
            pg8::EpiSwiglu E{(bf16_t*)(X + X_ACT), ssq0};
            pg8::gemm_phase<pg8::EpiSwiglu, pg8::StaticOrder, true>(lds, g, S, E, wave_s);
        } else if (KIND(2) && (j == 1 || j == 7)) {
            const float* hin = (ph == 2) ? in_ptr(lds, 0) : args.out;
            { pg8::Gemm g{(const bf16_t*)(X + X_ACT), WL + (j == 7 ? WO_D2 : WO_D1), nullptr, nullptr, FF}; pg8::StaticOrder S; S.init(M, DM, G, bx);
              pg8::EpiRes<0> E{hin, args.out, HB, ssq1, 0.5f, nullptr, nullptr};
              pg8::gemm_phase<pg8::EpiRes<0>, pg8::StaticOrder, false>(lds, g, S, E, wave_s); }
            if (j == 7) { pg8::Gemm g2{(const bf16_t*)(X + X_PB), WL + WO_PP, nullptr, nullptr, PLED}; pg8::StaticOrder S2; S2.init(M, DM, G, bx);
              pg8::EpiPlain E2{(bf16_t*)(X + X_T2), DM};
              pg8::gemm_phase<pg8::EpiPlain, pg8::StaticOrder, true>(lds, g2, S2, E2, wave_s); }
        } else if (KIND(3) && j == 2) {
            pg8::Gemm g{HB, WL + WO_IN, nullptr, nullptr, DM}; pg8::StaticOrder S; S.init(M, NIN, G, bx);
            pg8::EpiWin E{ws, ssq1};
            pg8::gemm_phase<pg8::EpiWin, pg8::StaticOrder, true>(lds, g, S, E, wave_s);
        } else if (KIND(4) && j == 3) { TID_LANE;
            bf16_t* Qb = (bf16_t*)(X + X_Q);
            const int gwd = vcu * NWAVES + (tid >> 6);
            for (int it = gwd; it < NBATCH * NHEAD * 64; it += NGW)
                attn_simple_item(it, Qb, (const bf16_t*)(X + X_K), (const bf16_t*)(X + X_V), Qb, (const float*)(ws + WS_KSUM), lds + (tid >> 6) * 16384, lane);
            convmix((const bf16_t*)(X + X_BG), (const bf16_t*)(X + X_U), in_ptr(lds, 4) + (size_t)L * 3 * CW, HB  , vcu * NWAVES * 64 + tid, NGW * 64);
        } else if (KIND(5) && j == 4) {
            pg8::Gemm g{HB  , WL + WO_C, (const bf16_t*)(X + X_Q)  , WL + WO_A, CW}; pg8::TwoSegOrder S; S.so.init(M, DM, G, bx);
            pg8::EpiMerge E{(const bf16_t*)(X + X_SGC), (const bf16_t*)(X + X_SGA), (bf16_t*)(X + X_MERGED)};
            pg8::gemm_phase<pg8::EpiMerge, pg8::TwoSegOrder, true>(lds, g, S, E, wave_s);
        } else if (KIND(6) && j == 5) {
            { pg8::Gemm g{(const bf16_t*)(X + X_MERGED), WL + WO_O, nullptr, nullptr, DM}; pg8::StaticOrder S; S.init(M, DM, G, bx);
              pg8::EpiRes<0> E{args.out, args.out, HB, ssq0, 1.0f, nullptr, nullptr};
              pg8::gemm_phase<pg8::EpiRes<0>, pg8::StaticOrder, false>(lds, g, S, E, wave_s); }
            TID_LANE; pb_convert(in_ptr(lds, 1) + (size_t)L * M * PLED, (bf16_t*)(X + X_PB), gw, NGW, lane);
        } else if (KIND(7) && j == 8) {
            pg8::Gemm g{HB, WL + WO_PG, nullptr, nullptr, DM}; pg8::StaticOrder S; S.init(M, DM, G, bx);
            pg8::EpiRes<1> E{args.out, args.out, HB, ssq0, 1.0f, ssq1, (const bf16_t*)(X + X_T2)};
            pg8::gemm_phase<pg8::EpiRes<1>, pg8::StaticOrder, false>(lds, g, S, E, wave_s);
        } else if (KIND(8) && j == 9) { TID_LANE;
            final_norm(args.out, ssq0, in_ptr(lds, 20), gw, NGW, lane);
        }
    }
}

extern "C" void kernel_launch(void* const* d_in, const int* in_sizes, int n_in, void* d_out, int out_size, void* d_ws, size_t ws_size, hipStream_t stream) {
    static int grid = 0;
    if (grid == 0) {
        if (n_in != 21 || in_sizes[0] != M * DM || out_size != M * DM || ws_size < WS_END) { fprintf(stderr, "kernel_launch: unexpected shapes / workspace (%d inputs, ws %zu)\n", n_in, ws_size); grid = -1; return; }
        int dev = 0, cus = 0;
        if (hipGetDevice(&dev) != hipSuccess || hipDeviceGetAttribute(&cus, hipDeviceAttributeMultiprocessorCount, dev) != hipSuccess) { grid = -1; return; }
        if (hipFuncSetAttribute((const void*)skel_fwd, hipFuncAttributeMaxDynamicSharedMemorySize, LDS_BYTES) != hipSuccess) { fprintf(stderr, "kernel_launch: hipFuncSetAttribute failed\n"); grid = -1; return; }
        (void)hipGetLastError();
        grid = 256;
        if (cus != 256) fprintf(stderr, "kernel_launch: device has %d CUs; this kernel is built for 256\n", cus);
    }
    if (grid < 0) return;
    (void)hipMemsetAsync((char*)d_ws + WS_CTL, 0, CTL_ZERO_BYTES, stream);
    Args a{};
    for (int i = 0; i < 21; ++i) a.in[i] = (const float*)d_in[i];
    a.out = (float*)d_out; a.ws = (unsigned char*)d_ws;
    for (int ph = 0; ph < NPHASE; ++ph) {
        a.ph_lo = ph; a.ph_hi = ph + 1;
        hipLaunchKernelGGL(skel_fwd, dim3(grid), dim3(NWAVES * 64), LDS_BYTES, stream, a);
    }
}
```

```cpp
#include <hip/hip_runtime.h>
#include <hip/hip_cooperative_groups.h>
#include <cstdio>
#include <cstdint>

#ifndef MK_ONE_LAUNCH
#define MK_ONE_LAUNCH 1
#endif

#define LAS __attribute__((address_space(3)))
#define GAS __attribute__((address_space(1)))
typedef unsigned short bf16_t;
typedef short bf16x8 __attribute__((ext_vector_type(8)));
typedef float f32x4 __attribute__((ext_vector_type(4)));
typedef float f32x2 __attribute__((ext_vector_type(2)));
typedef unsigned u32x4 __attribute__((ext_vector_type(4)));
typedef unsigned u32x2 __attribute__((ext_vector_type(2)));

constexpr int M = 16384, DM = 1024, FF = 2816, NGU = 2 * FF, NIN = 5120, SEQ = 4096, NBATCH = 4, NHEAD = 8, HD = 64, CW = 512, AW = 512, PLED = 256, DEPTH = 2, NBLK = 16;
constexpr float EPS = 1e-6f;
constexpr float LOG2E = 1.4426950408889634f;
constexpr float C2 = 0.125f * LOG2E;

constexpr size_t MiB = 1u << 20;
constexpr size_t WS_CTL = 0, CTL_ZERO_BYTES = 1 * MiB;
constexpr size_t WO_GU1 = 0, WO_D1 = WO_GU1 + (size_t)NGU * DM, WO_IN = WO_D1 + (size_t)DM * FF, WO_C = WO_IN + (size_t)NIN * DM, WO_A = WO_C + (size_t)DM * CW,
                 WO_O = WO_A + (size_t)DM * AW, WO_GU2 = WO_O + (size_t)DM * DM, WO_D2 = WO_GU2 + (size_t)NGU * DM, WO_PG = WO_D2 + (size_t)DM * FF, WO_PP = WO_PG + (size_t)DM * DM,
                 WL_ELEMS = WO_PP + (size_t)DM * PLED;
static_assert(WL_ELEMS == 25952256, "weight block");
constexpr size_t WS_W = 1 * MiB;
constexpr size_t WS_HB = 100 * MiB;
constexpr size_t WS_X = 132 * MiB;
constexpr size_t X_BG = 0, X_U = 16 * MiB, X_Q = 32 * MiB, X_K = 48 * MiB, X_V = 64 * MiB, X_SGC = 80 * MiB, X_SGA = 112 * MiB;
constexpr size_t X_ACT = 0, X_MERGED = 0, X_T2 = 88 * MiB, X_PB = 120 * MiB;
constexpr size_t WS_SSQ0 = 276 * MiB, WS_SSQ1 = WS_SSQ0 + 256 * 1024, WS_KSUM = WS_SSQ1 + 256 * 1024, WS_COS = 277 * MiB, WS_SIN = 279 * MiB, WS_END = 281 * MiB;
static_assert(WS_W + 2 * WL_ELEMS * 2 <= WS_HB, "weights fit");
static_assert((size_t)M * FF * 2 <= 88 * MiB, "ACT fits");

constexpr int RING_BYTES = 131072;
constexpr int LDSCTL_OFF = RING_BYTES, MISC_OFF = LDSCTL_OFF + 320;
constexpr int LDS_BYTES = 147456;
constexpr int NWAVES = 8;

#define LDS_WAIT() asm volatile("s_waitcnt lgkmcnt(0)" ::: "memory")
#define VM_WAIT() asm volatile("s_waitcnt vmcnt(0)" ::: "memory")
#define RLX_AGENT __ATOMIC_RELAXED, __HIP_MEMORY_SCOPE_AGENT

__device__ __forceinline__ unsigned f2bf(float f) { unsigned u = __builtin_bit_cast(unsigned, f); return (u + 0x7fffu + ((u >> 16) & 1u)) >> 16; }
__device__ __forceinline__ unsigned pk2(float lo, float hi) { return f2bf(lo) | (f2bf(hi) << 16); }
__device__ __forceinline__ unsigned cvt_pk_bf16(float lo, float hi) { unsigned r; asm volatile("v_cvt_pk_bf16_f32 %0, %1, %2" : "=v"(r) : "v"(lo), "v"(hi)); return r; }
__device__ __forceinline__ float bf_lo(unsigned w) { return __builtin_bit_cast(float, w << 16); }
__device__ __forceinline__ float bf_hi(unsigned w) { return __builtin_bit_cast(float, w & 0xffff0000u); }
__device__ __forceinline__ float rstd_of(const float* ssq, int r) { const f32x4 s = *(const f32x4*)(ssq + 4 * (size_t)r); return rsqrtf(((s.x + s.y) + (s.z + s.w)) * (1.0f / DM) + EPS); }
__device__ __forceinline__ int tid_now(int wave_s) { int l; asm volatile("v_mbcnt_lo_u32_b32 %0, -1, 0\n\tv_mbcnt_hi_u32_b32 %0, -1, %0" : "=v"(l)); return wave_s * 64 + l; }
template <class T> __device__ __forceinline__ T ldg(const void* base, unsigned boff) { return *(const T*)((const char*)base + boff); }
template <class T> __device__ __forceinline__ void stg(void* base, unsigned boff, T v) { *(T*)((char*)base + boff) = v; }
__device__ __forceinline__ float rstd_at(const float* ssq, int r) { const f32x4 s = ldg<f32x4>(ssq, (unsigned)r * 16u); return __builtin_amdgcn_rsqf(((s.x + s.y) + (s.z + s.w)) * (1.0f / DM) + EPS); }
__device__ __forceinline__ float shx(float v, int mask, int lane) { return __builtin_bit_cast(float, __builtin_amdgcn_ds_bpermute((lane ^ mask) << 2, __builtin_bit_cast(int, v))); }
__device__ __forceinline__ float sigmoidf_(float x) { return __builtin_amdgcn_rcpf(1.0f + __builtin_amdgcn_exp2f(-x * LOG2E)); }

namespace pg8 {
constexpr int BM = 256, BK = 64, HALF = 128, HTB = HALF * BK * 2, STAGE_BYTES = 8 * HTB, NXCD = 8, WGM = 8;
__host__ __device__ __forceinline__ int lds_byte(int r, int c) { const int st = (r >> 4) * 2 + (c >> 5), rr = r & 15, cc = c & 31, ob = rr * 64 + cc * 2; return st * 1024 + (ob ^ (((ob >> 9) & 1) << 5)); }
__host__ __device__ __forceinline__ void stage_rc(int b, int& R, int& C) { const int st = b / 1024, sb = b % 1024, swz = sb ^ (((sb >> 9) & 1) << 5); R = (st >> 1) * 16 + swz / 64; C = (st & 1) * 32 + (swz % 64) / 2; }
__host__ __device__ __forceinline__ int perm32(int rho) { const int n = rho >> 4, i = rho & 15; return 8 * (i >> 2) + 4 * n + (i & 3); }

struct Unit { int pm, pn, seg; };
struct Gemm { const bf16_t* A0; const bf16_t* B0; const bf16_t* A1; const bf16_t* B1; int K; };

struct StaticOrder {
    int nM, nN, nwg, G, c;
    __device__ void init(int M_, int N_, int G_, int c_) { nM = M_ / BM; nN = N_ / BM; nwg = nM * nN; G = G_; c = c_; }
    __device__ bool next(int i, Unit& u) const {
        const long L = (long)i * G + c; if (L >= nwg) return false;
        int wgid = (int)L; { const int q = nwg / NXCD, r = nwg % NXCD, xcd = wgid % NXCD, off = wgid / NXCD; wgid = (xcd < r ? xcd * (q + 1) : r * (q + 1) + (xcd - r) * q) + off; }
        const int nig = WGM * nN, gid = wgid / nig, fm = gid * WGM, gsz = (nM - fm) < WGM ? (nM - fm) : WGM;
        u.pm = fm + ((wgid % nig) % gsz); u.pn = (wgid % nig) / gsz; u.seg = 0; return true;
    }
};
struct TwoSegOrder {
    StaticOrder so;
    __device__ bool next(int i, Unit& u) const { if (i >= 2) return false; const bool ok = so.next(0, u); u.seg = i; return ok; }
};

template <class Epi, class Sched, bool ALIGN_EPI>
__device__ __forceinline__ void gemm_phase(LAS unsigned char* lds, const Gemm g, const Sched& S, const Epi& E, int wave_s) {
    const int tid = tid_now(wave_s), wid = __builtin_amdgcn_readfirstlane(tid >> 6), lane = tid & 63, wr = wid >> 2, wc = wid & 3, fr = lane & 15, fq = lane >> 4;
    const int K = g.K, nt = K / BK;
    unsigned voffA[2], voffB[2];
#pragma unroll
    for (int i = 0; i < 2; ++i) { int R, C; stage_rc(tid * 16 + i * 8192, R, C); const int Rb = Epi::PERM ? ((R & ~31) + perm32(R & 31)) : R;
        voffA[i] = (unsigned)(R * K + C) * 2u; voffB[i] = (unsigned)(Rb * K + C) * 2u; }
    const size_t kstep = (size_t)(BK * 2);
    const size_t hstep = (size_t)HALF * K * 2;
    const size_t tstep = 2 * hstep;
    const unsigned ldsw = (unsigned)wid * 1024u;
    const int aoff = lds_byte(wr * 64 + fr, fq * 8), boff = lds_byte(wc * 32 + fr, fq * 8);
#define PG8_SA(b, h) (((b) * 2 + (h)) * HTB)
#define PG8_SB(b, h) ((4 + (b) * 2 + (h)) * HTB)
#define PG8_STAGE(bufoff, gbase, voff) do { _Pragma("unroll") for (int _i = 0; _i < 2; ++_i) \
        __builtin_amdgcn_global_load_lds((const unsigned*)((const char*)(gbase) + (voff)[_i]), (LAS unsigned*)(lds + (bufoff) + ldsw + _i * 8192), 16, 0, 0); } while (0)
#define PG8_LDA(dst, b, h) do { _Pragma("unroll") for (int m = 0; m < 4; ++m) _Pragma("unroll") for (int k = 0; k < 2; ++k) dst[m][k] = *(const LAS bf16x8*)(lds + PG8_SA(b, h) + aoff + m * 2048 + k * 1024); } while (0)
#define PG8_LDB(dst, b, h) do { _Pragma("unroll") for (int n = 0; n < 2; ++n) _Pragma("unroll") for (int k = 0; k < 2; ++k) dst[n][k] = *(const LAS bf16x8*)(lds + PG8_SB(b, h) + boff + n * 2048 + k * 1024); } while (0)
#define PG8_MMA(ai, bj, At, Bt) do { __builtin_amdgcn_s_setprio(1); _Pragma("unroll") for (int m = 0; m < 4; ++m) _Pragma("unroll") for (int n = 0; n < 2; ++n) _Pragma("unroll") for (int k = 0; k < 2; ++k) \
        acc[ai][bj][m][n] = __builtin_amdgcn_mfma_f32_16x16x32_bf16(Bt[n][k], At[m][k], acc[ai][bj][m][n], 0, 0, 0); __builtin_amdgcn_s_setprio(0); } while (0)
#define PG8_WAIT_V(n) asm volatile("s_waitcnt vmcnt(" #n ")" ::: "memory")
#define PG8_WAIT_L(n) asm volatile("s_waitcnt lgkmcnt(" #n ")" ::: "memory")
#define PG8_BAR __builtin_amdgcn_s_barrier()
#define PG8_SCHED __builtin_amdgcn_sched_barrier(0)
    Unit cur, nxt; int ui = 0;
    if (!S.next(0, cur)) return;
    f32x4 acc[2][2][4][2];
#pragma unroll
    for (int a = 0; a < 2; ++a)
#pragma unroll
        for (int b = 0; b < 2; ++b)
#pragma unroll
            for (int m = 0; m < 4; ++m)
#pragma unroll
                for (int n = 0; n < 2; ++n) acc[a][b][m][n] = (f32x4){0.f, 0.f, 0.f, 0.f};
    bf16x8 At[4][2], B0[2][2], B1[2][2];
    const char* cA = (const char*)(cur.seg ? g.A1 : g.A0) + (size_t)cur.pm * tstep; const char* cB = (const char*)(cur.seg ? g.B1 : g.B0) + (size_t)cur.pn * tstep;
    PG8_STAGE(PG8_SB(0, 0), cB, voffB); PG8_STAGE(PG8_SB(0, 1), cB + hstep, voffB); PG8_STAGE(PG8_SA(0, 0), cA, voffA); PG8_STAGE(PG8_SA(0, 1), cA + hstep, voffA);
    if (wr == 1) PG8_BAR;
    PG8_WAIT_V(2); PG8_BAR;
    PG8_STAGE(PG8_SB(1, 0), cB + kstep, voffB); PG8_STAGE(PG8_SA(1, 0), cA + kstep, voffA); PG8_STAGE(PG8_SB(1, 1), cB + hstep + kstep, voffB);
    PG8_WAIT_V(6); PG8_BAR;
    for (;;) {
        const bool has_next = S.next(ui + 1, nxt);
        const char* nA = has_next ? (const char*)(nxt.seg ? g.A1 : g.A0) + (size_t)nxt.pm * tstep : cA; const char* nB = has_next ? (const char*)(nxt.seg ? g.B1 : g.B0) + (size_t)nxt.pn * tstep : cB;
        for (int t = 0; t < nt; t += 2) {
            const bool last = (t == nt - 2);
            const char* a1 = cA + (size_t)(t + 1) * kstep;
            const char* a2 = last ? nA : cA + (size_t)(t + 2) * kstep; const char* b2 = last ? nB : cB + (size_t)(t + 2) * kstep;
            const char* a3 = a2 + kstep; const char* b3 = b2 + kstep;
            PG8_LDB(B0, 0, 0); PG8_LDB(B1, 0, 1); PG8_SCHED; PG8_LDA(At, 0, 0); PG8_STAGE(PG8_SA(1, 1), a1 + hstep, voffA);
            PG8_WAIT_V(8); PG8_WAIT_L(0); PG8_BAR; PG8_MMA(0, 0, At, B0); PG8_MMA(0, 1, At, B1); PG8_BAR; PG8_SCHED;
            PG8_LDA(At, 0, 1); PG8_STAGE(PG8_SB(0, 0), b2, voffB); PG8_STAGE(PG8_SB(0, 1), b2 + hstep, voffB); PG8_STAGE(PG8_SA(0, 0), a2, voffA);
            PG8_WAIT_V(8); PG8_WAIT_L(0); PG8_BAR; PG8_MMA(1, 0, At, B0); PG8_MMA(1, 1, At, B1); PG8_BAR; PG8_SCHED;
            PG8_LDB(B0, 1, 0); PG8_LDB(B1, 1, 1); PG8_SCHED; PG8_LDA(At, 1, 0); PG8_STAGE(PG8_SA(0, 1), a2 + hstep, voffA);
            PG8_WAIT_V(8); PG8_WAIT_L(0); PG8_BAR; PG8_MMA(0, 0, At, B0); PG8_MMA(0, 1, At, B1); PG8_BAR; PG8_SCHED;
            PG8_LDA(At, 1, 1); PG8_STAGE(PG8_SB(1, 0), b3, voffB); PG8_STAGE(PG8_SB(1, 1), b3 + hstep, voffB); PG8_STAGE(PG8_SA(1, 0), a3, voffA);
            PG8_WAIT_V(8); PG8_WAIT_L(0); PG8_BAR; PG8_MMA(1, 0, At, B0); PG8_MMA(1, 1, At, B1); PG8_BAR; PG8_SCHED;
        }
        if constexpr (ALIGN_EPI) { if (wr == 0) PG8_BAR; }
        if constexpr (!Epi::AFTER_DRAIN) { const int l2 = tid_now(wave_s) & 63;
            E(acc, cur, wr, wc, l2 & 15, l2 >> 4); }
        if (!has_next) break;
        if (!(Epi::CARRY && nxt.seg != 0)) {
#pragma unroll
        for (int a = 0; a < 2; ++a)
#pragma unroll
            for (int b = 0; b < 2; ++b)
#pragma unroll
                for (int m = 0; m < 4; ++m)
#pragma unroll
                    for (int n = 0; n < 2; ++n) acc[a][b][m][n] = (f32x4){0.f, 0.f, 0.f, 0.f};
        }
        cur = nxt; cA = nA; cB = nB; ++ui;
        if constexpr (ALIGN_EPI) { if (wr == 1) PG8_BAR; }
    }
    PG8_WAIT_V(0);
    if constexpr (!ALIGN_EPI) { if (wr == 0) PG8_BAR; }
    PG8_BAR;
    if constexpr (Epi::AFTER_DRAIN) { const int l2 = tid_now(wave_s) & 63; E.fused(acc, cur, wr, wc, l2 & 15, l2 >> 4, lds, wid, l2); }
#undef PG8_SA
#undef PG8_SB
#undef PG8_STAGE
#undef PG8_LDA
#undef PG8_LDB
#undef PG8_MMA
#undef PG8_WAIT_V
#undef PG8_WAIT_L
#undef PG8_BAR
#undef PG8_SCHED
}

typedef f32x4 (&AccRef)[2][2][4][2];
#define ROWGROUP_BEGIN(r, expr) int r = (expr); asm volatile("" : "+v"(r) :: "memory")
__device__ __forceinline__ u32x4 pack8(const f32x4 a, const f32x4 b) { u32x4 w; w.x = cvt_pk_bf16(a[0], a[1]); w.y = cvt_pk_bf16(a[2], a[3]); w.z = cvt_pk_bf16(b[0], b[1]); w.w = cvt_pk_bf16(b[2], b[3]); return w; }
__device__ __forceinline__ void unpack8(const u32x4 t, f32x4& a, f32x4& b) { a = (f32x4){bf_lo(t.x), bf_hi(t.x), bf_lo(t.y), bf_hi(t.y)}; b = (f32x4){bf_lo(t.z), bf_hi(t.z), bf_lo(t.w), bf_hi(t.w)}; }

struct EpiSwiglu {
    static constexpr bool PERM = true, AFTER_DRAIN = false, CARRY = false;
    bf16_t* ACT; const float* ssq;
    __device__ __forceinline__ void operator()(AccRef acc, const Unit& u, int wr, int wc, int fr, int fq) const {
        const int row0 = u.pm * BM + wr * 64 + fr, col0 = u.pn * 128 + wc * 32 + 8 * fq;
#pragma unroll
        for (int ai = 0; ai < 2; ++ai)
#pragma unroll
            for (int m = 0; m < 4; ++m) { ROWGROUP_BEGIN(r, row0 + ai * HALF + m * 16); const float rs = rstd_at(ssq, r);
                f32x4 o0, o1;
#pragma unroll
                for (int i = 0; i < 4; ++i) { const float g0 = acc[ai][0][m][0][i] * rs, u0 = acc[ai][1][m][0][i] * rs, g1 = acc[ai][0][m][1][i] * rs, u1 = acc[ai][1][m][1][i] * rs;
                    o0[i] = g0 * u0 * sigmoidf_(g0); o1[i] = g1 * u1 * sigmoidf_(g1); }
                stg<u32x4>(ACT, (unsigned)(r * FF + col0) * 2u, pack8(o0, o1)); }
    }
};

struct EpiPlain {
    static constexpr bool PERM = true, AFTER_DRAIN = false, CARRY = false;
    bf16_t* O; int ldc;
    __device__ __forceinline__ void operator()(AccRef acc, const Unit& u, int wr, int wc, int fr, int fq) const {
        const int row0 = u.pm * BM + wr * 64 + fr, col0 = u.pn * BM + wc * 32 + 8 * fq;
#pragma unroll
        for (int ai = 0; ai < 2; ++ai)
#pragma unroll
            for (int m = 0; m < 4; ++m) { ROWGROUP_BEGIN(r, row0 + ai * HALF + m * 16);
#pragma unroll
                for (int bj = 0; bj < 2; ++bj) stg<u32x4>(O, (unsigned)(r * ldc + col0 + bj * HALF) * 2u, pack8(acc[ai][bj][m][0], acc[ai][bj][m][1])); }
    }
};

struct EpiWin {
    static constexpr bool PERM = true, AFTER_DRAIN = false, CARRY = false;
    unsigned char* ws; const float* ssq;
    __device__ __forceinline__ void operator()(AccRef acc, const Unit& u, int wr, int wc, int fr, int fq) const {
        const int pn = u.pn, row0 = u.pm * BM + wr * 64 + fr, cw = wc * 32 + 8 * fq;
        unsigned char* X = ws + WS_X;
        if (pn >= 2 && pn < 6) {
            const int col0 = (pn - 2) * 128 + cw;
#pragma unroll
            for (int ai = 0; ai < 2; ++ai)
#pragma unroll
                for (int m = 0; m < 4; ++m) { ROWGROUP_BEGIN(r, row0 + ai * HALF + m * 16); const float rs = rstd_at(ssq, r), rs2 = rs * rs;
                    stg<u32x4>(X + X_U, (unsigned)(r * CW + col0) * 2u, pack8(acc[ai][0][m][0] * acc[ai][1][m][0] * rs2, acc[ai][0][m][1] * acc[ai][1][m][1] * rs2)); }
        } else if (pn >= 6 && pn < 10) {
            const bool isk = pn >= 8; const int head = ((pn - 6) & 1) * 4 + wc, dd0 = 8 * fq; unsigned char* dst = X + (isk ? X_K : X_Q); const float osc = isk ? 1.0f : C2;
            f32x4 cs[2][2];
#pragma unroll
            for (int a = 0; a < 2; ++a)
#pragma unroll
                for (int b = 0; b < 2; ++b) cs[a][b] = (f32x4){0.f, 0.f, 0.f, 0.f};
#pragma unroll
            for (int ai = 0; ai < 2; ++ai)
#pragma unroll
                for (int m = 0; m < 4; ++m) { ROWGROUP_BEGIN(r, row0 + ai * HALF + m * 16); const float rs = rstd_at(ssq, r);
                    f32x4 y1[2], y2[2];
#pragma unroll
                    for (int n = 0; n < 2; ++n) { const f32x4 c4 = ldg<f32x4>(ws + WS_COS, (unsigned)(r * 32 + dd0 + 4 * n) * 4u), s4 = ldg<f32x4>(ws + WS_SIN, (unsigned)(r * 32 + dd0 + 4 * n) * 4u);
                        const f32x4 x1 = acc[ai][0][m][n] * rs, x2 = acc[ai][1][m][n] * rs;
                        y1[n] = x1 * c4 - x2 * s4; y2[n] = x2 * c4 + x1 * s4; cs[0][n] += y1[n]; cs[1][n] += y2[n]; }
                    stg<u32x4>(dst, (unsigned)(r * AW + head * 64 + dd0) * 2u, pack8(y1[0] * osc, y1[1] * osc));
                    stg<u32x4>(dst, (unsigned)(r * AW + head * 64 + 32 + dd0) * 2u, pack8(y2[0] * osc, y2[1] * osc));
                    asm volatile("" : "+v"(cs[0][0]), "+v"(cs[0][1]), "+v"(cs[1][0]), "+v"(cs[1][1])); }
            if (isk) {
#pragma unroll
                for (int b = 0; b < 2; ++b)
#pragma unroll
                    for (int n = 0; n < 2; ++n)
#pragma unroll
                        for (int i = 0; i < 4; ++i) { const int ln = fq * 16 + fr; float v = cs[b][n][i]; v += shx(v, 1, ln); v += shx(v, 2, ln); v += shx(v, 4, ln); v += shx(v, 8, ln); cs[b][n][i] = v; }
                if (fr == 0) {
#pragma unroll
                    for (int b = 0; b < 2; ++b)
#pragma unroll
                        for (int n = 0; n < 2; ++n) stg<f32x4>(ws + WS_KSUM, (unsigned)((u.pm * 2 + wr) * 512 + head * 64 + dd0 + 32 * b + 4 * n) * 4u, cs[b][n]); }
            }
        } else {
            const bool gate = pn >= 12; unsigned char* dst; int ldc, colt;
            if (pn < 2) { dst = X + X_BG; ldc = CW; colt = pn * 256; } else if (pn < 12) { dst = X + X_V; ldc = AW; colt = (pn - 10) * 256; }
            else if (pn < 16) { dst = X + X_SGC; ldc = DM; colt = (pn - 12) * 256; } else { dst = X + X_SGA; ldc = DM; colt = (pn - 16) * 256; }
#pragma unroll
            for (int ai = 0; ai < 2; ++ai)
#pragma unroll
                for (int m = 0; m < 4; ++m) { ROWGROUP_BEGIN(r, row0 + ai * HALF + m * 16); const float rs = rstd_at(ssq, r);
#pragma unroll
                    for (int bj = 0; bj < 2; ++bj) { f32x4 v0 = acc[ai][bj][m][0] * rs, v1 = acc[ai][bj][m][1] * rs;
                        if (gate) {
#pragma unroll
                            for (int i = 0; i < 4; ++i) { v0[i] = sigmoidf_(v0[i]); v1[i] = sigmoidf_(v1[i]); } }
                        stg<u32x4>(dst, (unsigned)(r * ldc + colt + bj * HALF + cw) * 2u, pack8(v0, v1)); } }
        }
    }
};

struct EpiMerge {
    static constexpr bool PERM = true, AFTER_DRAIN = false, CARRY = true;
    const bf16_t *SGC, *SGA; bf16_t* MG;
    __device__ __forceinline__ void operator()(AccRef acc, const Unit& u, int wr, int wc, int fr, int fq) const {
        const int row0 = u.pm * BM + wr * 64 + fr, col0 = u.pn * BM + wc * 32 + 8 * fq;
#pragma unroll
        for (int ai = 0; ai < 2; ++ai)
#pragma unroll
            for (int m = 0; m < 4; ++m) { ROWGROUP_BEGIN(r, row0 + ai * HALF + m * 16);
#pragma unroll
                for (int bj = 0; bj < 2; ++bj) { const unsigned off = (unsigned)(r * DM + col0 + bj * HALF) * 2u;
                    f32x4 sa0, sa1; unpack8(ldg<u32x4>(SGA, off), sa0, sa1);
#pragma unroll
                    for (int i = 0; i < 4; ++i) { sa0[i] = fmaxf(sa0[i], 1e-30f); sa1[i] = fmaxf(sa1[i], 1e-30f); }
                    if (u.seg == 0) { f32x4 sc0, sc1; unpack8(ldg<u32x4>(SGC, off), sc0, sc1);
#pragma unroll
                        for (int i = 0; i < 4; ++i) { acc[ai][bj][m][0][i] *= sc0[i] / sa0[i]; acc[ai][bj][m][1][i] *= sc1[i] / sa1[i]; }
                    } else stg<u32x4>(MG, off, pack8(acc[ai][bj][m][0] * sa0, acc[ai][bj][m][1] * sa1)); } }
    }
};

template <int MODE> struct EpiRes {
    static constexpr bool PERM = true, AFTER_DRAIN = true, CARRY = false;
    const float* hin; float* hout; bf16_t* HB; float* ssq_out; float scale; const float* ssq_in; const bf16_t* T2;
    __device__ __forceinline__ void fused(AccRef acc, const Unit& u, int wr, int wc, int fr, int fq, LAS unsigned char* lds, int wid, int lane) const {
        LAS float* P = (LAS float*)lds;
        const int row0 = u.pm * BM + wr * 64 + fr, col0 = u.pn * BM + wc * 32 + 8 * fq;
#pragma unroll
        for (int ai = 0; ai < 2; ++ai)
#pragma unroll
            for (int m = 0; m < 4; ++m) { ROWGROUP_BEGIN(r, row0 + ai * HALF + m * 16); float q = 0.f;
                float rs = 1.f; if (MODE == 1) rs = rstd_at(ssq_in, r);
#pragma unroll
                for (int bj = 0; bj < 2; ++bj) { const unsigned e = (unsigned)(r * DM + col0 + bj * HALF);
                    const f32x4 h0 = ldg<f32x4>(hin, e * 4u), h1 = ldg<f32x4>(hin, e * 4u + 16u);
                    f32x4 y0, y1;
                    if (MODE == 0) { y0 = h0 + acc[ai][bj][m][0] * scale; y1 = h1 + acc[ai][bj][m][1] * scale; }
                    else { f32x4 t0, t1; unpack8(ldg<u32x4>(T2, e * 2u), t0, t1);
#pragma unroll
                        for (int i = 0; i < 4; ++i) { y0[i] = h0[i] + sigmoidf_(acc[ai][bj][m][0][i] * rs) * t0[i]; y1[i] = h1[i] + sigmoidf_(acc[ai][bj][m][1][i] * rs) * t1[i]; } }
                    stg<f32x4>(hout, e * 4u, y0); stg<f32x4>(hout, e * 4u + 16u, y1);
                    stg<u32x4>(HB, e * 2u, pack8(y0, y1));
                    q += (y0[0] * y0[0] + y0[1] * y0[1]) + (y0[2] * y0[2] + y0[3] * y0[3]) + (y1[0] * y1[0] + y1[1] * y1[1]) + (y1[2] * y1[2] + y1[3] * y1[3]); }
                q += shx(q, 16, lane); q += shx(q, 32, lane);
                if (fq == 0) P[(ai * HALF + wr * 64 + m * 16 + fr) * 4 + wc] = q; }
        asm volatile("s_waitcnt lgkmcnt(0)" ::: "memory"); __builtin_amdgcn_s_barrier(); asm volatile("" ::: "memory");
        const int t = wid * 64 + lane;
        if (t < 256) { const f32x4 p = *(const LAS f32x4*)(P + 4 * t); ssq_out[(size_t)(u.pm * BM + t) * 4 + u.pn] = (p.x + p.y) + (p.z + p.w); }
        asm volatile("s_waitcnt lgkmcnt(0)" ::: "memory"); __builtin_amdgcn_s_barrier(); asm volatile("" ::: "memory");
    }
};
}

__device__ __forceinline__ float wave_sum(float v, int lane) {
#pragma unroll
    for (int o = 1; o < 64; o <<= 1) v += shx(v, o, lane);
    return v;
}
__device__ __forceinline__ void transpose_item(const float* W, int Ksrc, int Nsrc, const float* gain, bf16_t* WT, int k0, int n0, int drow0, LAS float* scr, int lane) {
#pragma unroll 8
    for (int i = 0; i < 32; ++i) { const int kk = 2 * i + (lane >> 5); float v = W[(size_t)(k0 + kk) * Nsrc + n0 + (lane & 31)]; if (gain) v *= gain[k0 + kk]; scr[kk * 33 + (lane & 31)] = v; }
    LDS_WAIT(); asm volatile("" ::: "memory");
    const int c = lane & 7;
#pragma unroll
    for (int j = 0; j < 4; ++j) { const int n = (lane >> 3) + 8 * j; const LAS float* s = scr + (8 * c) * 33 + n;
        u32x4 o; o.x = pk2(s[0 * 33], s[1 * 33]); o.y = pk2(s[2 * 33], s[3 * 33]); o.z = pk2(s[4 * 33], s[5 * 33]); o.w = pk2(s[6 * 33], s[7 * 33]);
        *(u32x4*)(WT + (size_t)(drow0 + n) * Ksrc + k0 + 8 * c) = o; }
    LDS_WAIT(); asm volatile("" ::: "memory");
}
__device__ __forceinline__ int win_drow(int c) {
    if (c < 512) return c;
    if (c < 1024) { const int ch = c - 512; return 512 + (ch >> 7) * 256 + (ch & 127); }
    if (c < 1536) { const int ch = c - 1024; return 512 + (ch >> 7) * 256 + 128 + (ch & 127); }
    if (c < 2560) { const int base = c < 2048 ? 1536 : 2048; const int cq = c - base, head = cq >> 6, half = (cq >> 5) & 1; return base + (head >> 2) * 256 + half * 128 + (head & 3) * 32; }
    return c;
}
__device__ __forceinline__ int gu_drow(int c, int isup) { return (c >> 7) * 256 + isup * 128 + (c & 127); }

struct Args { const float* in[21]; float* out; unsigned char* ws; int ph_lo, ph_hi; };

constexpr int TBL_OFF = MISC_OFF + 128;
__device__ __forceinline__ const float* in_ptr(LAS unsigned char* lds, int k) {
    const LAS unsigned* t = (const LAS unsigned*)(lds + TBL_OFF) + 2 * k; unsigned lo = t[0], hi = t[1];
    lo = __builtin_amdgcn_readfirstlane(lo); hi = __builtin_amdgcn_readfirstlane(hi);
    return (const float*)(GAS const float*)(((unsigned long long)hi << 32) | lo);
}
__device__ __forceinline__ unsigned char* launder(unsigned char* p) { size_t z = 0; asm volatile("" : "+s"(z)); return p + z; }

constexpr int I_GU = 16 * 88, I_D = 44 * 32, I_IN = 16 * 160, I_C = 8 * 32, I_O = 16 * 32, I_PP = 4 * 32;
constexpr int ITEMS_L = 6 * I_GU + I_IN + 2 * I_C + 2 * I_O + I_PP;
static_assert(I_GU == I_D && ITEMS_L == 12672, "item counts");

__device__ __forceinline__ void p0_weights(LAS unsigned char* lds, bf16_t* Wb, LAS float* scr, int gw, int NGW, int lane) {
    for (int gi = gw; gi < 2 * ITEMS_L; gi += NGW) {
        const int L = gi >= ITEMS_L ? 1 : 0; int r = gi - L * ITEMS_L; bf16_t* WL = Wb + (size_t)L * WL_ELEMS;
        if (r < 4 * I_GU) { const int which = r / I_GU; r -= which * I_GU; const int kb = r / 88, nb = r % 88; const int ffn = which >> 1, isup = which & 1;
            const float* src = in_ptr(lds, (ffn ? 11 : 8) + isup) + (size_t)L * DM * FF; const float* gn = in_ptr(lds, ffn ? 16 : 14) + L * DM;
            transpose_item(src, DM, FF, gn, WL + (ffn ? WO_GU2 : WO_GU1), 64 * kb, 32 * nb, gu_drow(32 * nb, isup), scr, lane); continue; }
        r -= 4 * I_GU;
        if (r < 2 * I_D) { const int ffn = r / I_D; r -= ffn * I_D; const int kb = r / 32, nb = r % 32;
            transpose_item(in_ptr(lds, ffn ? 13 : 10) + (size_t)L * FF * DM, FF, DM, nullptr, WL + (ffn ? WO_D2 : WO_D1), 64 * kb, 32 * nb, 32 * nb, scr, lane); continue; }
        r -= 2 * I_D;
        if (r < I_IN) { const int kb = r / 160, nb = r % 160;
            transpose_item(in_ptr(lds, 3) + (size_t)L * DM * NIN, DM, NIN, in_ptr(lds, 15) + L * DM, WL + WO_IN, 64 * kb, 32 * nb, win_drow(32 * nb), scr, lane); continue; }
        r -= I_IN;
        if (r < 2 * I_C) { const int which = r / I_C; r -= which * I_C; const int kb = r / 32, nb = r % 32;
            transpose_item(in_ptr(lds, 5 + which) + (size_t)L * CW * DM, CW, DM, nullptr, WL + (which ? WO_A : WO_C), 64 * kb, 32 * nb, 32 * nb, scr, lane); continue; }
        r -= 2 * I_C;
        if (r < 2 * I_O) { const int which = r / I_O; r -= which * I_O; const int kb = r / 32, nb = r % 32;
            const float* gn = which ? in_ptr(lds, 17) + L * DM : nullptr;
            transpose_item(in_ptr(lds, which ? 18 : 7) + (size_t)L * DM * DM, DM, DM, gn, WL + (which ? WO_PG : WO_O), 64 * kb, 32 * nb, 32 * nb, scr, lane); continue; }
        r -= 2 * I_O;
        { const int kb = r / 32, nb = r % 32;
            transpose_item(in_ptr(lds, 19) + (size_t)L * PLED * DM, PLED, DM, nullptr, WL + WO_PP, 64 * kb, 32 * nb, 32 * nb, scr, lane); }
    }
}
__device__ __forceinline__ void p0_rows(const float* x, const int* pos, bf16_t* HB, float* ssq0, float* rcos, float* rsin, int gw, int NGW, int lane) {
    for (int m = gw; m < M; m += NGW) {
        const f32x4* xr = (const f32x4*)(x + (size_t)m * DM) + lane; f32x4 v[4]; float s = 0.f;
#pragma unroll
        for (int j = 0; j < 4; ++j) { v[j] = xr[64 * j]; s += (v[j].x * v[j].x + v[j].y * v[j].y) + (v[j].z * v[j].z + v[j].w * v[j].w); }
        s = wave_sum(s, lane);
        u32x2* o8 = (u32x2*)(HB + (size_t)m * DM) + lane;
#pragma unroll
        for (int j = 0; j < 4; ++j) { u32x2 w; w.x = pk2(v[j].x, v[j].y); w.y = pk2(v[j].z, v[j].w); o8[64 * j] = w; }
        if (lane == 0) *(f32x4*)(ssq0 + 4 * (size_t)m) = (f32x4){s, 0.f, 0.f, 0.f};
        if (lane < 32) { const float p = (float)pos[m]; const float invf = exp2f(-(float)lane * (13.287712379549449f / 32.0f)); const float ang = p * invf; float sn, cs; sincosf(ang, &sn, &cs);
            rcos[(size_t)m * 32 + lane] = cs; rsin[(size_t)m * 32 + lane] = sn; }
    }
}
__device__ __forceinline__ void pb_convert(const float* p, bf16_t* PB, int gw, int NGW, int lane) {
    for (int m = gw; m < M; m += NGW) { const f32x4 v = *((const f32x4*)(p + (size_t)m * PLED) + lane); u32x2 w; w.x = pk2(v.x, v.y); w.y = pk2(v.z, v.w); *((u32x2*)(PB + (size_t)m * PLED) + lane) = w; }
}
__device__ __forceinline__ void convmix(const bf16_t* BG, const bf16_t* U, const float* cwt, bf16_t* CM, int gt, int NGT) {
    for (int e = gt; e < M * (CW / 8); e += NGT) { const int r = e >> 6, c8 = (e & 63) * 8, s = r & (SEQ - 1);
        const u32x4 b = *(const u32x4*)(BG + (size_t)r * CW + c8), u0 = *(const u32x4*)(U + (size_t)r * CW + c8);
        u32x4 u1 = (u32x4){0u, 0u, 0u, 0u}, u2 = (u32x4){0u, 0u, 0u, 0u};
        if (s >= 1) u1 = *(const u32x4*)(U + (size_t)(r - 1) * CW + c8);
        if (s >= 2) u2 = *(const u32x4*)(U + (size_t)(r - 2) * CW + c8);
        float o[8];
#pragma unroll
        for (int j = 0; j < 4; ++j) { const unsigned bw = b[j], w0 = u0[j], w1 = u1[j], w2 = u2[j]; const int c = c8 + 2 * j;
            o[2 * j] = bf_lo(bw) * (cwt[c] * bf_lo(w2) + cwt[CW + c] * bf_lo(w1) + cwt[2 * CW + c] * bf_lo(w0));
            o[2 * j + 1] = bf_hi(bw) * (cwt[c + 1] * bf_hi(w2) + cwt[CW + c + 1] * bf_hi(w1) + cwt[2 * CW + c + 1] * bf_hi(w0)); }
        u32x4 w; w.x = pk2(o[0], o[1]); w.y = pk2(o[2], o[3]); w.z = pk2(o[4], o[5]); w.w = pk2(o[6], o[7]);
        *(u32x4*)(CM + (size_t)r * CW + c8) = w; }
}
__device__ __forceinline__ void final_norm(float* h, const float* ssq, const float* g, int gw, int NGW, int lane) {
    for (int m = gw; m < M; m += NGW) { const float rs = rstd_of(ssq, m); f32x4* hr = (f32x4*)(h + (size_t)m * DM) + lane; const f32x4* gr = (const f32x4*)g + lane;
#pragma unroll
        for (int j = 0; j < 4; ++j) { const f32x4 v = hr[64 * j], gg = gr[64 * j]; hr[64 * j] = v * rs * gg; } }
}

__device__ __forceinline__ void attn_simple_item(int it, const bf16_t* Q, const bf16_t* Kb, const bf16_t* Vb, bf16_t* O, const float* KSUM, LAS unsigned char* wl, int lane) {
    const int b = it >> 9, h = (it >> 6) & 7, qc = it & 63, blk = qc >> 2;
    const int s = qc * 64 + lane; const size_t row = (size_t)b * SEQ + s;
    float q[64];
    { const bf16_t* qp = Q + row * AW + h * 64;
#pragma unroll
      for (int j = 0; j < 8; ++j) { const u32x4 v = *(const u32x4*)(qp + 8 * j); q[8 * j] = bf_lo(v.x); q[8 * j + 1] = bf_hi(v.x); q[8 * j + 2] = bf_lo(v.y); q[8 * j + 3] = bf_hi(v.y); q[8 * j + 4] = bf_lo(v.z); q[8 * j + 5] = bf_hi(v.z); q[8 * j + 6] = bf_lo(v.w); q[8 * j + 7] = bf_hi(v.w); } }
    unsigned sel;
    if (blk <= 3) sel = (1u << blk) - 1u;
    else { float v1 = -INFINITY, v2 = -INFINITY, v3 = -INFINITY; int i1 = 31, i2 = 31, i3 = 31;
        for (int n = 0; n < blk; ++n) { const float* k0 = KSUM + ((size_t)(b * NBLK + n) * 2) * 512 + h * 64; float sc = 0.f;
#pragma unroll
            for (int d = 0; d < 64; d += 4) { const f32x4 a = *(const f32x4*)(k0 + d), c = *(const f32x4*)(k0 + 512 + d);
                sc += q[d] * (a.x + c.x) + q[d + 1] * (a.y + c.y) + q[d + 2] * (a.z + c.z) + q[d + 3] * (a.w + c.w); }
            if (sc > v1) { v3 = v2; i3 = i2; v2 = v1; i2 = i1; v1 = sc; i1 = n; }
            else if (sc > v2) { v3 = v2; i3 = i2; v2 = sc; i2 = n; }
            else if (sc > v3) { v3 = sc; i3 = n; } }
        sel = (1u << i1) | (1u << i2) | (1u << i3); }
    float mx = -INFINITY, l = 0.f; float o[64];
#pragma unroll
    for (int d = 0; d < 64; ++d) o[d] = 0.f;
    for (int bi = 0; bi <= blk; ++bi) { const int n = (bi == 0) ? blk : bi - 1; const bool own = (bi == 0); const bool lane_sel = own || ((sel >> n) & 1u);
        if (!__any(lane_sel)) continue;
        for (int t4 = 0; t4 < 4; ++t4) { const int key0 = n * 256 + t4 * 64;
            if (own && key0 > qc * 64 + 63) break;
            const bf16_t* kp = Kb + ((size_t)b * SEQ + key0) * AW + h * 64; const bf16_t* vp = Vb + ((size_t)b * SEQ + key0) * AW + h * 64;
#pragma unroll
            for (int j = 0; j < 8; ++j) { const int ri = (lane >> 3) + 8 * j, ch = lane & 7;
                const u32x4 kv = *(const u32x4*)(kp + (size_t)ri * AW + ch * 8), vv = *(const u32x4*)(vp + (size_t)ri * AW + ch * 8);
                *(LAS u32x4*)(wl + ri * 128 + ch * 16) = kv; *(LAS u32x4*)(wl + 8192 + ri * 128 + ch * 16) = vv; }
            for (int j = 0; j < 64; ++j) { float sc = 0.f;
#pragma unroll
                for (int c = 0; c < 8; ++c) { const u32x4 kk = *(const LAS u32x4*)(wl + j * 128 + c * 16);
                    sc += q[8 * c] * bf_lo(kk.x) + q[8 * c + 1] * bf_hi(kk.x) + q[8 * c + 2] * bf_lo(kk.y) + q[8 * c + 3] * bf_hi(kk.y) + q[8 * c + 4] * bf_lo(kk.z) + q[8 * c + 5] * bf_hi(kk.z) + q[8 * c + 6] * bf_lo(kk.w) + q[8 * c + 7] * bf_hi(kk.w); }
                const bool valid = own ? (key0 + j <= s) : lane_sel;
                sc = valid ? sc : -INFINITY;
                const float mn = fmaxf(mx, sc); const float alpha = __builtin_amdgcn_exp2f(mx - mn), p = __builtin_amdgcn_exp2f(sc - mn);
                l = l * alpha + p; mx = mn;
#pragma unroll
                for (int c = 0; c < 8; ++c) { const u32x4 vv = *(const LAS u32x4*)(wl + 8192 + j * 128 + c * 16);
                    o[8 * c] = o[8 * c] * alpha + p * bf_lo(vv.x); o[8 * c + 1] = o[8 * c + 1] * alpha + p * bf_hi(vv.x); o[8 * c + 2] = o[8 * c + 2] * alpha + p * bf_lo(vv.y); o[8 * c + 3] = o[8 * c + 3] * alpha + p * bf_hi(vv.y);
                    o[8 * c + 4] = o[8 * c + 4] * alpha + p * bf_lo(vv.z); o[8 * c + 5] = o[8 * c + 5] * alpha + p * bf_hi(vv.z); o[8 * c + 6] = o[8 * c + 6] * alpha + p * bf_lo(vv.w); o[8 * c + 7] = o[8 * c + 7] * alpha + p * bf_hi(vv.w); }
            }
        }
    }
    const float inv = 1.0f / l; bf16_t* op = O + row * AW + h * 64;
#pragma unroll
    for (int j = 0; j < 8; ++j) { u32x4 w; w.x = pk2(o[8 * j] * inv, o[8 * j + 1] * inv); w.y = pk2(o[8 * j + 2] * inv, o[8 * j + 3] * inv); w.z = pk2(o[8 * j + 4] * inv, o[8 * j + 5] * inv); w.w = pk2(o[8 * j + 6] * inv, o[8 * j + 7] * inv);
        *(u32x4*)(op + 8 * j) = w; }
}

#define XB_TMO      128
#define XB_XCNT(j)  (256  + 64 * (j))
#define XB_XSUB(j)  (1280 + 64 * (j))
#define XB_XGEN(j)  (2304 + 64 * (j))
#define XB_TOP      3328
#define XB_TOPGEN   3392
#define XCD_BAR_WORDS 3456
#define XB_SPIN_CAP (1u << 22)
constexpr int CW_BAR = 4096;
__device__ __forceinline__ unsigned xb_ld(unsigned* p)              { return __hip_atomic_load(p, __ATOMIC_RELAXED, __HIP_MEMORY_SCOPE_AGENT); }
__device__ __forceinline__ unsigned xb_add(unsigned* p, unsigned v) { return __hip_atomic_fetch_add(p, v, __ATOMIC_RELAXED, __HIP_MEMORY_SCOPE_AGENT); }
__device__ __forceinline__ unsigned xb_xcc_id() { return (unsigned)__builtin_amdgcn_s_getreg((3 << 11) | 20) & 0xFu; }
#define XB_SPIN(cond, bar) do { unsigned _sp = 0; while (cond) { __builtin_amdgcn_s_sleep(1); \
    if ((++_sp & 255u) == 0u) { if (xb_ld(&(bar)[XB_TMO])) break; if (_sp > XB_SPIN_CAP) { atomicAdd(&(bar)[XB_TMO], 1u); break; } } } } while (0)
__device__ __forceinline__ void xcd_barrier_complete(unsigned* bar, unsigned x, unsigned& nloc, unsigned& nx) {
    const unsigned G = gridDim.x * gridDim.y * gridDim.z;
    unsigned sum, cnt, mine, sp = 0u;
    for (;;) {
        sum = 0u; cnt = 0u; mine = 0u;
#pragma unroll
        for (unsigned j = 0; j < 16; ++j) { const unsigned c = xb_ld(&bar[XB_XCNT(j)]); sum += c; cnt += (c > 0u) ? 1u : 0u; mine = (j == x) ? c : mine; }
        if (sum == G) break;
        __builtin_amdgcn_s_sleep(1);
        if ((++sp & 255u) == 0u) { if (xb_ld(&bar[XB_TMO])) break; if (sp > XB_SPIN_CAP) { atomicAdd(&bar[XB_TMO], 1u); break; } }
    }
    nloc = mine > 0u ? mine : 1u; nx = cnt > 0u ? cnt : 1u;
}
__device__ __forceinline__ void xcd_barrier(unsigned* bar, unsigned x, volatile LAS unsigned* st, bool leader_thread) {
    asm volatile("s_waitcnt vmcnt(0)" ::: "memory");
    __syncthreads();
    if (leader_thread) {
        __builtin_amdgcn_s_waitcnt(0);
        unsigned nloc = st[0], nx = st[1];
        if (nloc == 0u) { xcd_barrier_complete(bar, x, nloc, nx); st[0] = nloc; st[1] = nx; }
        const unsigned old = xb_add(&bar[XB_XSUB(x)], 1u);
        const unsigned gen = old / nloc;
        if (old + 1u == (gen + 1u) * nloc) {
            __builtin_amdgcn_fence(__ATOMIC_RELEASE, "agent");
            asm volatile("s_waitcnt vmcnt(0)" ::: "memory");
            const unsigned og = xb_add(&bar[XB_TOP], 1u);
            const unsigned tg = og / nx;
            if (og + 1u == (tg + 1u) * nx) xb_add(&bar[XB_TOPGEN], 1u);
            else XB_SPIN(xb_ld(&bar[XB_TOPGEN]) == tg, bar);
            __builtin_amdgcn_fence(__ATOMIC_ACQUIRE, "agent");
            xb_add(&bar[XB_XGEN(x)], 1u);
            asm volatile("s_waitcnt vmcnt(0)" ::: "memory");
        } else {
            XB_SPIN(xb_ld(&bar[XB_XGEN(x)]) == gen, bar);
            __builtin_amdgcn_fence(__ATOMIC_ACQUIRE, "agent");
            asm volatile("s_waitcnt vmcnt(0)" ::: "memory");
        }
    }
    __syncthreads();
}

constexpr int NPHASE = 20;
#ifndef KMASK
#define KMASK 0x3FF
#endif
#define KIND(j) ((KMASK >> (j)) & 1)
__global__ void __launch_bounds__(NWAVES * 64, 2) skel_fwd(Args args) {
    extern __shared__ __attribute__((aligned(16))) unsigned char lds_raw[];
    LAS unsigned char* lds = (LAS unsigned char*)lds_raw;
    const int wave_s = __builtin_amdgcn_readfirstlane(threadIdx.x >> 6);
    {
        const int t0 = threadIdx.x;
        for (int u = t0; u < (LDS_BYTES - LDSCTL_OFF) / 4; u += NWAVES * 64) ((LAS unsigned*)(lds + LDSCTL_OFF))[u] = 0u;
        __syncthreads();
        if (t0 == 0) { LAS unsigned long long* t = (LAS unsigned long long*)(lds + TBL_OFF);
#pragma unroll
            for (int i = 0; i < 21; ++i) t[i] = (unsigned long long)args.in[i]; }
        __syncthreads();
    }
#if MK_ONE_LAUNCH
    const unsigned xcc = xb_xcc_id();
    if (threadIdx.x == 0) (void)xb_add((unsigned*)(args.ws + WS_CTL) + CW_BAR + XB_XCNT(xcc), 1u);
#endif
    for (int ph = args.ph_lo; ph < args.ph_hi; ++ph) {
        unsigned char* ws = launder(args.ws);
        int bx_ = blockIdx.x, G_ = gridDim.x; asm volatile("" : "+s"(bx_), "+s"(G_));
        const int G = G_, bx = bx_, vcu = (G % 8 == 0) ? (bx % 8) * (G / 8) + bx / 8 : bx, NGW = G * NWAVES;
        const int wave = wave_s, gw = vcu * NWAVES + wave;
#define TID_LANE const int tid = tid_now(wave_s), lane = tid & 63
        const int L = (ph - 1) / 9, j = (ph == 0) ? -1 : (ph == NPHASE - 1) ? 9 : (ph - 1) % 9;
        bf16_t* HB = (bf16_t*)(ws + WS_HB); unsigned char* X = ws + WS_X;
        const bf16_t* WL = (const bf16_t*)(ws + WS_W) + (size_t)L * WL_ELEMS;
        float *ssq0 = (float*)(ws + WS_SSQ0), *ssq1 = (float*)(ws + WS_SSQ1);
        if (KIND(0) && j == -1) { TID_LANE;
            p0_weights(lds, (bf16_t*)(ws + WS_W), (LAS float*)(lds + wave * 16384), gw, NGW, lane);
            p0_rows(in_ptr(lds, 0), (const int*)in_ptr(lds, 2), HB, ssq0, (float*)(ws + WS_COS), (float*)(ws + WS_SIN), gw, NGW, lane);
        } else if (KIND(1) && (j == 0 || j == 6)) {
            pg8::Gemm g{HB, WL + (j ? WO_GU2 : WO_GU1), nullptr, nullptr, DM}; pg8::StaticOrder S; S.init(M, NGU, G, bx);
            pg8::EpiSwiglu E{(bf16_t*)(X + X_ACT), ssq0};
            pg8::gemm_phase<pg8::EpiSwiglu, pg8::StaticOrder, true>(lds, g, S, E, wave_s);
        } else if (KIND(2) && (j == 1 || j == 7)) {
            const float* hin = (ph == 2) ? in_ptr(lds, 0) : args.out;
            { pg8::Gemm g{(const bf16_t*)(X + X_ACT), WL + (j == 7 ? WO_D2 : WO_D1), nullptr, nullptr, FF}; pg8::StaticOrder S; S.init(M, DM, G, bx);
              pg8::EpiRes<0> E{hin, args.out, HB, ssq1, 0.5f, nullptr, nullptr};
              pg8::gemm_phase<pg8::EpiRes<0>, pg8::StaticOrder, false>(lds, g, S, E, wave_s); }
            if (j == 7) { pg8::Gemm g2{(const bf16_t*)(X + X_PB), WL + WO_PP, nullptr, nullptr, PLED}; pg8::StaticOrder S2; S2.init(M, DM, G, bx);
              pg8::EpiPlain E2{(bf16_t*)(X + X_T2), DM};
              pg8::gemm_phase<pg8::EpiPlain, pg8::StaticOrder, true>(lds, g2, S2, E2, wave_s); }
        } else if (KIND(3) && j == 2) {
            pg8::Gemm g{HB, WL + WO_IN, nullptr, nullptr, DM}; pg8::StaticOrder S; S.init(M, NIN, G, bx);
            pg8::EpiWin E{ws, ssq1};
            pg8::gemm_phase<pg8::EpiWin, pg8::StaticOrder, true>(lds, g, S, E, wave_s);
        } else if (KIND(4) && j == 3) { TID_LANE;
            bf16_t* Qb = (bf16_t*)(X + X_Q);
            const int gwd = vcu * NWAVES + (tid >> 6);
            for (int it = gwd; it < NBATCH * NHEAD * 64; it += NGW)
                attn_simple_item(it, Qb, (const bf16_t*)(X + X_K), (const bf16_t*)(X + X_V), Qb, (const float*)(ws + WS_KSUM), lds + (tid >> 6) * 16384, lane);
            convmix((const bf16_t*)(X + X_BG), (const bf16_t*)(X + X_U), in_ptr(lds, 4) + (size_t)L * 3 * CW, HB  , vcu * NWAVES * 64 + tid, NGW * 64);
        } else if (KIND(5) && j == 4) {
            pg8::Gemm g{HB  , WL + WO_C, (const bf16_t*)(X + X_Q)  , WL + WO_A, CW}; pg8::TwoSegOrder S; S.so.init(M, DM, G, bx);
            pg8::EpiMerge E{(const bf16_t*)(X + X_SGC), (const bf16_t*)(X + X_SGA), (bf16_t*)(X + X_MERGED)};
            pg8::gemm_phase<pg8::EpiMerge, pg8::TwoSegOrder, true>(lds, g, S, E, wave_s);
        } else if (KIND(6) && j == 5) {
            { pg8::Gemm g{(const bf16_t*)(X + X_MERGED), WL + WO_O, nullptr, nullptr, DM}; pg8::StaticOrder S; S.init(M, DM, G, bx);
              pg8::EpiRes<0> E{args.out, args.out, HB, ssq0, 1.0f, nullptr, nullptr};
              pg8::gemm_phase<pg8::EpiRes<0>, pg8::StaticOrder, false>(lds, g, S, E, wave_s); }
            TID_LANE; pb_convert(in_ptr(lds, 1) + (size_t)L * M * PLED, (bf16_t*)(X + X_PB), gw, NGW, lane);
        } else if (KIND(7) && j == 8) {
            pg8::Gemm g{HB, WL + WO_PG, nullptr, nullptr, DM}; pg8::StaticOrder S; S.init(M, DM, G, bx);
            pg8::EpiRes<1> E{args.out, args.out, HB, ssq0, 1.0f, ssq1, (const bf16_t*)(X + X_T2)};
            pg8::gemm_phase<pg8::EpiRes<1>, pg8::StaticOrder, false>(lds, g, S, E, wave_s);
        } else if (KIND(8) && j == 9) { TID_LANE;
            final_norm(args.out, ssq0, in_ptr(lds, 20), gw, NGW, lane);
        }
#if MK_ONE_LAUNCH
        if (ph + 1 < args.ph_hi) {
            if (ph == 0) cooperative_groups::this_grid().sync();
            else { const int tb = tid_now(wave_s); xcd_barrier((unsigned*)(args.ws + WS_CTL) + CW_BAR, xcc, (volatile LAS unsigned*)(lds + MISC_OFF) + 8, tb == 0); }
        }
#endif
    }
}

extern "C" void kernel_launch(void* const* d_in, const int* in_sizes, int n_in, void* d_out, int out_size, void* d_ws, size_t ws_size, hipStream_t stream) {
    static int grid = 0;
    if (grid == 0) {
        if (n_in != 21 || in_sizes[0] != M * DM || out_size != M * DM || ws_size < WS_END) { fprintf(stderr, "kernel_launch: unexpected shapes / workspace (%d inputs, ws %zu)\n", n_in, ws_size); grid = -1; return; }
        int dev = 0, cus = 0;
        if (hipGetDevice(&dev) != hipSuccess || hipDeviceGetAttribute(&cus, hipDeviceAttributeMultiprocessorCount, dev) != hipSuccess) { grid = -1; return; }
        if (hipFuncSetAttribute((const void*)skel_fwd, hipFuncAttributeMaxDynamicSharedMemorySize, LDS_BYTES) != hipSuccess) { fprintf(stderr, "kernel_launch: hipFuncSetAttribute failed\n"); grid = -1; return; }
        (void)hipGetLastError();
        grid = 256;
        if (cus != 256) fprintf(stderr, "kernel_launch: device has %d CUs; this kernel is built for 256\n", cus);
    }
    if (grid < 0) return;
    (void)hipMemsetAsync((char*)d_ws + WS_CTL, 0, CTL_ZERO_BYTES, stream);
    Args a{};
    for (int i = 0; i < 21; ++i) a.in[i] = (const float*)d_in[i];
    a.out = (float*)d_out; a.ws = (unsigned char*)d_ws;
#if MK_ONE_LAUNCH
    a.ph_lo = 0; a.ph_hi = NPHASE;
    void* kargs[] = {&a};
    const hipError_t e = hipLaunchCooperativeKernel((const void*)skel_fwd, dim3(grid), dim3(NWAVES * 64), kargs, LDS_BYTES, stream);
    if (e != hipSuccess) fprintf(stderr, "kernel_launch: cooperative launch failed: %s\n", hipGetErrorString(e));
#else
    for (int ph = 0; ph < NPHASE; ++ph) {
        a.ph_lo = ph; a.ph_hi = ph + 1;
        hipLaunchKernelGGL(skel_fwd, dim3(grid), dim3(NWAVES * 64), LDS_BYTES, stream, a);
    }
#endif
}
```

```cpp
#include <hip/hip_runtime.h>
#include <hip/hip_cooperative_groups.h>
#include <cstdio>
#include <cstdint>

#ifndef MK_ONE_LAUNCH
#define MK_ONE_LAUNCH 1
#endif

#define LAS __attribute__((address_space(3)))
#define GAS __attribute__((address_space(1)))
typedef unsigned short bf16_t;
typedef short bf16x8 __attribute__((ext_vector_type(8)));
typedef float f32x4 __attribute__((ext_vector_type(4)));
typedef float f32x2 __attribute__((ext_vector_type(2)));
typedef unsigned u32x4 __attribute__((ext_vector_type(4)));
typedef unsigned u32x2 __attribute__((ext_vector_type(2)));

constexpr int M = 16384, DM = 1024, FF = 2816, NGU = 2 * FF, NIN = 5120, SEQ = 4096, NBATCH = 4, NHEAD = 8, HD = 64, CW = 512, AW = 512, PLED = 256, DEPTH = 2, NBLK = 16;
constexpr float EPS = 1e-6f;
constexpr float LOG2E = 1.4426950408889634f;
constexpr float C2 = 0.125f * LOG2E;

constexpr size_t MiB = 1u << 20;
constexpr size_t WS_CTL = 0, CTL_ZERO_BYTES = 1 * MiB;
constexpr size_t WO_GU1 = 0, WO_D1 = WO_GU1 + (size_t)NGU * DM, WO_IN = WO_D1 + (size_t)DM * FF, WO_C = WO_IN + (size_t)NIN * DM, WO_A = WO_C + (size_t)DM * CW,
                 WO_O = WO_A + (size_t)DM * AW, WO_GU2 = WO_O + (size_t)DM * DM, WO_D2 = WO_GU2 + (size_t)NGU * DM, WO_PG = WO_D2 + (size_t)DM * FF, WO_PP = WO_PG + (size_t)DM * DM,
                 WL_ELEMS = WO_PP + (size_t)DM * PLED;
static_assert(WL_ELEMS == 25952256, "weight block");
constexpr size_t WS_W = 1 * MiB;
constexpr size_t WS_HB = 100 * MiB;
constexpr size_t WS_X = 132 * MiB;
constexpr size_t X_BG = 0, X_U = 16 * MiB, X_Q = 32 * MiB, X_K = 48 * MiB, X_V = 64 * MiB, X_SGC = 80 * MiB, X_SGA = 112 * MiB;
constexpr size_t X_ACT = 0, X_MERGED = 0, X_T2 = 88 * MiB, X_PB = 120 * MiB;
constexpr size_t WS_SSQ0 = 276 * MiB, WS_SSQ1 = WS_SSQ0 + 256 * 1024, WS_KSUM = WS_SSQ1 + 256 * 1024, WS_COS = 277 * MiB, WS_SIN = 279 * MiB, WS_END = 281 * MiB;
static_assert(WS_W + 2 * WL_ELEMS * 2 <= WS_HB, "weights fit");
static_assert((size_t)M * FF * 2 <= 88 * MiB, "ACT fits");

constexpr int RING_BYTES = 131072;
constexpr int LDSCTL_OFF = RING_BYTES, MISC_OFF = LDSCTL_OFF + 320;
constexpr int LDS_BYTES = 147456;
constexpr int NWAVES = 8;

#define LDS_WAIT() asm volatile("s_waitcnt lgkmcnt(0)" ::: "memory")
#define VM_WAIT() asm volatile("s_waitcnt vmcnt(0)" ::: "memory")
#define RLX_AGENT __ATOMIC_RELAXED, __HIP_MEMORY_SCOPE_AGENT

__device__ __forceinline__ unsigned f2bf(float f) { unsigned u = __builtin_bit_cast(unsigned, f); return (u + 0x7fffu + ((u >> 16) & 1u)) >> 16; }
__device__ __forceinline__ unsigned pk2(float lo, float hi) { return f2bf(lo) | (f2bf(hi) << 16); }
__device__ __forceinline__ unsigned cvt_pk_bf16(float lo, float hi) { unsigned r; asm volatile("v_cvt_pk_bf16_f32 %0, %1, %2" : "=v"(r) : "v"(lo), "v"(hi)); return r; }
__device__ __forceinline__ float bf_lo(unsigned w) { return __builtin_bit_cast(float, w << 16); }
__device__ __forceinline__ float bf_hi(unsigned w) { return __builtin_bit_cast(float, w & 0xffff0000u); }
__device__ __forceinline__ float rstd_of(const float* ssq, int r) { const f32x4 s = *(const f32x4*)(ssq + 4 * (size_t)r); return rsqrtf(((s.x + s.y) + (s.z + s.w)) * (1.0f / DM) + EPS); }
__device__ __forceinline__ int tid_now(int wave_s) { int l; asm volatile("v_mbcnt_lo_u32_b32 %0, -1, 0\n\tv_mbcnt_hi_u32_b32 %0, -1, %0" : "=v"(l)); return wave_s * 64 + l; }
template <class T> __device__ __forceinline__ T ldg(const void* base, unsigned boff) { return *(const T*)((const char*)base + boff); }
template <class T> __device__ __forceinline__ void stg(void* base, unsigned boff, T v) { *(T*)((char*)base + boff) = v; }
__device__ __forceinline__ float rstd_at(const float* ssq, int r) { const f32x4 s = ldg<f32x4>(ssq, (unsigned)r * 16u); return __builtin_amdgcn_rsqf(((s.x + s.y) + (s.z + s.w)) * (1.0f / DM) + EPS); }
__device__ __forceinline__ float shx(float v, int mask, int lane) { return __builtin_bit_cast(float, __builtin_amdgcn_ds_bpermute((lane ^ mask) << 2, __builtin_bit_cast(int, v))); }
__device__ __forceinline__ float sigmoidf_(float x) { return __builtin_amdgcn_rcpf(1.0f + __builtin_amdgcn_exp2f(-x * LOG2E)); }

namespace pg8 {
constexpr int BM = 256, BK = 64, HALF = 128, HTB = HALF * BK * 2, STAGE_BYTES = 8 * HTB, NXCD = 8, WGM = 8;
__host__ __device__ __forceinline__ int lds_byte(int r, int c) { const int st = (r >> 4) * 2 + (c >> 5), rr = r & 15, cc = c & 31, ob = rr * 64 + cc * 2; return st * 1024 + (ob ^ (((ob >> 9) & 1) << 5)); }
__host__ __device__ __forceinline__ void stage_rc(int b, int& R, int& C) { const int st = b / 1024, sb = b % 1024, swz = sb ^ (((sb >> 9) & 1) << 5); R = (st >> 1) * 16 + swz / 64; C = (st & 1) * 32 + (swz % 64) / 2; }
__host__ __device__ __forceinline__ int perm32(int rho) { const int n = rho >> 4, i = rho & 15; return 8 * (i >> 2) + 4 * n + (i & 3); }

struct Unit { int pm, pn, seg; };
struct Gemm { const bf16_t* A0; const bf16_t* B0; const bf16_t* A1; const bf16_t* B1; int K; };

struct StaticOrder {
    int nM, nN, nwg, G, c;
    __device__ void init(int M_, int N_, int G_, int c_) { nM = M_ / BM; nN = N_ / BM; nwg = nM * nN; G = G_; c = c_; }
    __device__ bool next(int i, Unit& u) const {
        const long L = (long)i * G + c; if (L >= nwg) return false;
        int wgid = (int)L; { const int q = nwg / NXCD, r = nwg % NXCD, xcd = wgid % NXCD, off = wgid / NXCD; wgid = (xcd < r ? xcd * (q + 1) : r * (q + 1) + (xcd - r) * q) + off; }
        const int nig = WGM * nN, gid = wgid / nig, fm = gid * WGM, gsz = (nM - fm) < WGM ? (nM - fm) : WGM;
        u.pm = fm + ((wgid % nig) % gsz); u.pn = (wgid % nig) / gsz; u.seg = 0; return true;
    }
};
struct TwoSegOrder {
    StaticOrder so;
    __device__ bool next(int i, Unit& u) const { if (i >= 2) return false; const bool ok = so.next(0, u); u.seg = i; return ok; }
};

template <class Epi, class Sched, bool ALIGN_EPI>
__device__ __forceinline__ void gemm_phase(LAS unsigned char* lds, const Gemm g, const Sched& S, const Epi& E, int wave_s) {
    const int tid = tid_now(wave_s), wid = __builtin_amdgcn_readfirstlane(tid >> 6), lane = tid & 63, wr = wid >> 2, wc = wid & 3, fr = lane & 15, fq = lane >> 4;
    const int K = g.K, nt = K / BK;
    unsigned voffA[2], voffB[2];
#pragma unroll
    for (int i = 0; i < 2; ++i) { int R, C; stage_rc(tid * 16 + i * 8192, R, C); const int Rb = Epi::PERM ? ((R & ~31) + perm32(R & 31)) : R;
        voffA[i] = (unsigned)(R * K + C) * 2u; voffB[i] = (unsigned)(Rb * K + C) * 2u; }
    const size_t kstep = (size_t)(BK * 2);
    const size_t hstep = (size_t)HALF * K * 2;
    const size_t tstep = 2 * hstep;
    const unsigned ldsw = (unsigned)wid * 1024u;
    const int aoff = lds_byte(wr * 64 + fr, fq * 8), boff = lds_byte(wc * 32 + fr, fq * 8);
#define PG8_SA(b, h) (((b) * 2 + (h)) * HTB)
#define PG8_SB(b, h) ((4 + (b) * 2 + (h)) * HTB)
#define PG8_STAGE(bufoff, gbase, voff) do { _Pragma("unroll") for (int _i = 0; _i < 2; ++_i) \
        __builtin_amdgcn_global_load_lds((const unsigned*)((const char*)(gbase) + (voff)[_i]), (LAS unsigned*)(lds + (bufoff) + ldsw + _i * 8192), 16, 0, 0); } while (0)
#define PG8_LDA(dst, b, h) do { _Pragma("unroll") for (int m = 0; m < 4; ++m) _Pragma("unroll") for (int k = 0; k < 2; ++k) dst[m][k] = *(const LAS bf16x8*)(lds + PG8_SA(b, h) + aoff + m * 2048 + k * 1024); } while (0)
#define PG8_LDB(dst, b, h) do { _Pragma("unroll") for (int n = 0; n < 2; ++n) _Pragma("unroll") for (int k = 0; k < 2; ++k) dst[n][k] = *(const LAS bf16x8*)(lds + PG8_SB(b, h) + boff + n * 2048 + k * 1024); } while (0)
#define PG8_MMA(ai, bj, At, Bt) do { __builtin_amdgcn_s_setprio(1); _Pragma("unroll") for (int m = 0; m < 4; ++m) _Pragma("unroll") for (int n = 0; n < 2; ++n) _Pragma("unroll") for (int k = 0; k < 2; ++k) \
        acc[ai][bj][m][n] = __builtin_amdgcn_mfma_f32_16x16x32_bf16(Bt[n][k], At[m][k], acc[ai][bj][m][n], 0, 0, 0); __builtin_amdgcn_s_setprio(0); } while (0)
#define PG8_WAIT_V(n) asm volatile("s_waitcnt vmcnt(" #n ")" ::: "memory")
#define PG8_WAIT_L(n) asm volatile("s_waitcnt lgkmcnt(" #n ")" ::: "memory")
#define PG8_BAR __builtin_amdgcn_s_barrier()
#define PG8_SCHED __builtin_amdgcn_sched_barrier(0)
    Unit cur, nxt; int ui = 0;
    if (!S.next(0, cur)) return;
    f32x4 acc[2][2][4][2];
#pragma unroll
    for (int a = 0; a < 2; ++a)
#pragma unroll
        for (int b = 0; b < 2; ++b)
#pragma unroll
            for (int m = 0; m < 4; ++m)
#pragma unroll
                for (int n = 0; n < 2; ++n) acc[a][b][m][n] = (f32x4){0.f, 0.f, 0.f, 0.f};
    bf16x8 At[4][2], B0[2][2], B1[2][2];
    const char* cA = (const char*)(cur.seg ? g.A1 : g.A0) + (size_t)cur.pm * tstep; const char* cB = (const char*)(cur.seg ? g.B1 : g.B0) + (size_t)cur.pn * tstep;
    PG8_STAGE(PG8_SB(0, 0), cB, voffB); PG8_STAGE(PG8_SB(0, 1), cB + hstep, voffB); PG8_STAGE(PG8_SA(0, 0), cA, voffA); PG8_STAGE(PG8_SA(0, 1), cA + hstep, voffA);
    if (wr == 1) PG8_BAR;
    PG8_WAIT_V(2); PG8_BAR;
    PG8_STAGE(PG8_SB(1, 0), cB + kstep, voffB); PG8_STAGE(PG8_SA(1, 0), cA + kstep, voffA); PG8_STAGE(PG8_SB(1, 1), cB + hstep + kstep, voffB);
    PG8_WAIT_V(6); PG8_BAR;
    for (;;) {
        const bool has_next = S.next(ui + 1, nxt);
        const char* nA = has_next ? (const char*)(nxt.seg ? g.A1 : g.A0) + (size_t)nxt.pm * tstep : cA; const char* nB = has_next ? (const char*)(nxt.seg ? g.B1 : g.B0) + (size_t)nxt.pn * tstep : cB;
        for (int t = 0; t < nt; t += 2) {
            const bool last = (t == nt - 2);
            const char* a1 = cA + (size_t)(t + 1) * kstep;
            const char* a2 = last ? nA : cA + (size_t)(t + 2) * kstep; const char* b2 = last ? nB : cB + (size_t)(t + 2) * kstep;
            const char* a3 = a2 + kstep; const char* b3 = b2 + kstep;
            PG8_LDB(B0, 0, 0); PG8_LDB(B1, 0, 1); PG8_SCHED; PG8_LDA(At, 0, 0); PG8_STAGE(PG8_SA(1, 1), a1 + hstep, voffA);
            PG8_WAIT_V(8); PG8_WAIT_L(0); PG8_BAR; PG8_MMA(0, 0, At, B0); PG8_MMA(0, 1, At, B1); PG8_BAR; PG8_SCHED;
            PG8_LDA(At, 0, 1); PG8_STAGE(PG8_SB(0, 0), b2, voffB); PG8_STAGE(PG8_SB(0, 1), b2 + hstep, voffB); PG8_STAGE(PG8_SA(0, 0), a2, voffA);
            PG8_WAIT_V(8); PG8_WAIT_L(0); PG8_BAR; PG8_MMA(1, 0, At, B0); PG8_MMA(1, 1, At, B1); PG8_BAR; PG8_SCHED;
            PG8_LDB(B0, 1, 0); PG8_LDB(B1, 1, 1); PG8_SCHED; PG8_LDA(At, 1, 0); PG8_STAGE(PG8_SA(0, 1), a2 + hstep, voffA);
            PG8_WAIT_V(8); PG8_WAIT_L(0); PG8_BAR; PG8_MMA(0, 0, At, B0); PG8_MMA(0, 1, At, B1); PG8_BAR; PG8_SCHED;
            PG8_LDA(At, 1, 1); PG8_STAGE(PG8_SB(1, 0), b3, voffB); PG8_STAGE(PG8_SB(1, 1), b3 + hstep, voffB); PG8_STAGE(PG8_SA(1, 0), a3, voffA);
            PG8_WAIT_V(8); PG8_WAIT_L(0); PG8_BAR; PG8_MMA(1, 0, At, B0); PG8_MMA(1, 1, At, B1); PG8_BAR; PG8_SCHED;
        }
        if constexpr (ALIGN_EPI) { if (wr == 0) PG8_BAR; }
        if constexpr (!Epi::AFTER_DRAIN) { const int l2 = tid_now(wave_s) & 63;
            E(acc, cur, wr, wc, l2 & 15, l2 >> 4); }
        if (!has_next) break;
        if (!(Epi::CARRY && nxt.seg != 0)) {
#pragma unroll
        for (int a = 0; a < 2; ++a)
#pragma unroll
            for (int b = 0; b < 2; ++b)
#pragma unroll
                for (int m = 0; m < 4; ++m)
#pragma unroll
                    for (int n = 0; n < 2; ++n) acc[a][b][m][n] = (f32x4){0.f, 0.f, 0.f, 0.f};
        }
        cur = nxt; cA = nA; cB = nB; ++ui;
        if constexpr (ALIGN_EPI) { if (wr == 1) PG8_BAR; }
    }
    PG8_WAIT_V(0);
    if constexpr (!ALIGN_EPI) { if (wr == 0) PG8_BAR; }
    PG8_BAR;
    if constexpr (Epi::AFTER_DRAIN) { const int l2 = tid_now(wave_s) & 63; E.fused(acc, cur, wr, wc, l2 & 15, l2 >> 4, lds, wid, l2); }
#undef PG8_SA
#undef PG8_SB
#undef PG8_STAGE
#undef PG8_LDA
#undef PG8_LDB
#undef PG8_MMA
#undef PG8_WAIT_V
#undef PG8_WAIT_L
#undef PG8_BAR
#undef PG8_SCHED
}

typedef f32x4 (&AccRef)[2][2][4][2];
#define ROWGROUP_BEGIN(r, expr) int r = (expr); asm volatile("" : "+v"(r) :: "memory")
__device__ __forceinline__ u32x4 pack8(const f32x4 a, const f32x4 b) { u32x4 w; w.x = cvt_pk_bf16(a[0], a[1]); w.y = cvt_pk_bf16(a[2], a[3]); w.z = cvt_pk_bf16(b[0], b[1]); w.w = cvt_pk_bf16(b[2], b[3]); return w; }
__device__ __forceinline__ void unpack8(const u32x4 t, f32x4& a, f32x4& b) { a = (f32x4){bf_lo(t.x), bf_hi(t.x), bf_lo(t.y), bf_hi(t.y)}; b = (f32x4){bf_lo(t.z), bf_hi(t.z), bf_lo(t.w), bf_hi(t.w)}; }

struct EpiSwiglu {
    static constexpr bool PERM = true, AFTER_DRAIN = false, CARRY = false;
    bf16_t* ACT; const float* ssq;
    __device__ __forceinline__ void operator()(AccRef acc, const Unit& u, int wr, int wc, int fr, int fq) const {
        const int row0 = u.pm * BM + wr * 64 + fr, col0 = u.pn * 128 + wc * 32 + 8 * fq;
#pragma unroll
        for (int ai = 0; ai < 2; ++ai)
#pragma unroll
            for (int m = 0; m < 4; ++m) { ROWGROUP_BEGIN(r, row0 + ai * HALF + m * 16); const float rs = rstd_at(ssq, r);
                f32x4 o0, o1;
#pragma unroll
                for (int i = 0; i < 4; ++i) { const float g0 = acc[ai][0][m][0][i] * rs, u0 = acc[ai][1][m][0][i] * rs, g1 = acc[ai][0][m][1][i] * rs, u1 = acc[ai][1][m][1][i] * rs;
                    o0[i] = g0 * u0 * sigmoidf_(g0); o1[i] = g1 * u1 * sigmoidf_(g1); }
                stg<u32x4>(ACT, (unsigned)(r * FF + col0) * 2u, pack8(o0, o1)); }
    }
};

struct EpiPlain {
    static constexpr bool PERM = true, AFTER_DRAIN = false, CARRY = false;
    bf16_t* O; int ldc;
    __device__ __forceinline__ void operator()(AccRef acc, const Unit& u, int wr, int wc, int fr, int fq) const {
        const int row0 = u.pm * BM + wr * 64 + fr, col0 = u.pn * BM + wc * 32 + 8 * fq;
#pragma unroll
        for (int ai = 0; ai < 2; ++ai)
#pragma unroll
            for (int m = 0; m < 4; ++m) { ROWGROUP_BEGIN(r, row0 + ai * HALF + m * 16);
#pragma unroll
                for (int bj = 0; bj < 2; ++bj) stg<u32x4>(O, (unsigned)(r * ldc + col0 + bj * HALF) * 2u, pack8(acc[ai][bj][m][0], acc[ai][bj][m][1])); }
    }
};

struct EpiWin {
    static constexpr bool PERM = true, AFTER_DRAIN = false, CARRY = false;
    unsigned char* ws; const float* ssq;
    __device__ __forceinline__ void operator()(AccRef acc, const Unit& u, int wr, int wc, int fr, int fq) const {
        const int pn = u.pn, row0 = u.pm * BM + wr * 64 + fr, cw = wc * 32 + 8 * fq;
        unsigned char* X = ws + WS_X;
        if (pn >= 2 && pn < 6) {
            const int col0 = (pn - 2) * 128 + cw;
#pragma unroll
            for (int ai = 0; ai < 2; ++ai)
#pragma unroll
                for (int m = 0; m < 4; ++m) { ROWGROUP_BEGIN(r, row0 + ai * HALF + m * 16); const float rs = rstd_at(ssq, r), rs2 = rs * rs;
                    stg<u32x4>(X + X_U, (unsigned)(r * CW + col0) * 2u, pack8(acc[ai][0][m][0] * acc[ai][1][m][0] * rs2, acc[ai][0][m][1] * acc[ai][1][m][1] * rs2)); }
        } else if (pn >= 6 && pn < 10) {
            const bool isk = pn >= 8; const int head = ((pn - 6) & 1) * 4 + wc, dd0 = 8 * fq; unsigned char* dst = X + (isk ? X_K : X_Q); const float osc = isk ? 1.0f : C2;
            f32x4 cs[2][2];
#pragma unroll
            for (int a = 0; a < 2; ++a)
#pragma unroll
                for (int b = 0; b < 2; ++b) cs[a][b] = (f32x4){0.f, 0.f, 0.f, 0.f};
#pragma unroll
            for (int ai = 0; ai < 2; ++ai)
#pragma unroll
                for (int m = 0; m < 4; ++m) { ROWGROUP_BEGIN(r, row0 + ai * HALF + m * 16); const float rs = rstd_at(ssq, r);
                    f32x4 y1[2], y2[2];
#pragma unroll
                    for (int n = 0; n < 2; ++n) { const f32x4 c4 = ldg<f32x4>(ws + WS_COS, (unsigned)(r * 32 + dd0 + 4 * n) * 4u), s4 = ldg<f32x4>(ws + WS_SIN, (unsigned)(r * 32 + dd0 + 4 * n) * 4u);
                        const f32x4 x1 = acc[ai][0][m][n] * rs, x2 = acc[ai][1][m][n] * rs;
                        y1[n] = x1 * c4 - x2 * s4; y2[n] = x2 * c4 + x1 * s4; cs[0][n] += y1[n]; cs[1][n] += y2[n]; }
                    stg<u32x4>(dst, (unsigned)(r * AW + head * 64 + dd0) * 2u, pack8(y1[0] * osc, y1[1] * osc));
                    stg<u32x4>(dst, (unsigned)(r * AW + head * 64 + 32 + dd0) * 2u, pack8(y2[0] * osc, y2[1] * osc));
                    asm volatile("" : "+v"(cs[0][0]), "+v"(cs[0][1]), "+v"(cs[1][0]), "+v"(cs[1][1])); }
            if (isk) {
#pragma unroll
                for (int b = 0; b < 2; ++b)
#pragma unroll
                    for (int n = 0; n < 2; ++n)
#pragma unroll
                        for (int i = 0; i < 4; ++i) { const int ln = fq * 16 + fr; float v = cs[b][n][i]; v += shx(v, 1, ln); v += shx(v, 2, ln); v += shx(v, 4, ln); v += shx(v, 8, ln); cs[b][n][i] = v; }
                if (fr == 0) {
#pragma unroll
                    for (int b = 0; b < 2; ++b)
#pragma unroll
                        for (int n = 0; n < 2; ++n) stg<f32x4>(ws + WS_KSUM, (unsigned)((u.pm * 2 + wr) * 512 + head * 64 + dd0 + 32 * b + 4 * n) * 4u, cs[b][n]); }
            }
        } else {
            const bool gate = pn >= 12; unsigned char* dst; int ldc, colt;
            if (pn < 2) { dst = X + X_BG; ldc = CW; colt = pn * 256; } else if (pn < 12) { dst = X + X_V; ldc = AW; colt = (pn - 10) * 256; }
            else if (pn < 16) { dst = X + X_SGC; ldc = DM; colt = (pn - 12) * 256; } else { dst = X + X_SGA; ldc = DM; colt = (pn - 16) * 256; }
#pragma unroll
            for (int ai = 0; ai < 2; ++ai)
#pragma unroll
                for (int m = 0; m < 4; ++m) { ROWGROUP_BEGIN(r, row0 + ai * HALF + m * 16); const float rs = rstd_at(ssq, r);
#pragma unroll
                    for (int bj = 0; bj < 2; ++bj) { f32x4 v0 = acc[ai][bj][m][0] * rs, v1 = acc[ai][bj][m][1] * rs;
                        if (gate) {
#pragma unroll
                            for (int i = 0; i < 4; ++i) { v0[i] = sigmoidf_(v0[i]); v1[i] = sigmoidf_(v1[i]); } }
                        stg<u32x4>(dst, (unsigned)(r * ldc + colt + bj * HALF + cw) * 2u, pack8(v0, v1)); } }
        }
    }
};

struct EpiMerge {
    static constexpr bool PERM = true, AFTER_DRAIN = false, CARRY = true;
    const bf16_t *SGC, *SGA; bf16_t* MG;
    __device__ __forceinline__ void operator()(AccRef acc, const Unit& u, int wr, int wc, int fr, int fq) const {
        const int row0 = u.pm * BM + wr * 64 + fr, col0 = u.pn * BM + wc * 32 + 8 * fq;
#pragma unroll
        for (int ai = 0; ai < 2; ++ai)
#pragma unroll
            for (int m = 0; m < 4; ++m) { ROWGROUP_BEGIN(r, row0 + ai * HALF + m * 16);
#pragma unroll
                for (int bj = 0; bj < 2; ++bj) { const unsigned off = (unsigned)(r * DM + col0 + bj * HALF) * 2u;
                    f32x4 sa0, sa1; unpack8(ldg<u32x4>(SGA, off), sa0, sa1);
#pragma unroll
                    for (int i = 0; i < 4; ++i) { sa0[i] = fmaxf(sa0[i], 1e-30f); sa1[i] = fmaxf(sa1[i], 1e-30f); }
                    if (u.seg == 0) { f32x4 sc0, sc1; unpack8(ldg<u32x4>(SGC, off), sc0, sc1);
#pragma unroll
                        for (int i = 0; i < 4; ++i) { acc[ai][bj][m][0][i] *= sc0[i] / sa0[i]; acc[ai][bj][m][1][i] *= sc1[i] / sa1[i]; }
                    } else stg<u32x4>(MG, off, pack8(acc[ai][bj][m][0] * sa0, acc[ai][bj][m][1] * sa1)); } }
    }
};

template <int MODE> struct EpiRes {
    static constexpr bool PERM = true, AFTER_DRAIN = true, CARRY = false;
    const float* hin; float* hout; bf16_t* HB; float* ssq_out; float scale; const float* ssq_in; const bf16_t* T2;
    __device__ __forceinline__ void fused(AccRef acc, const Unit& u, int wr, int wc, int fr, int fq, LAS unsigned char* lds, int wid, int lane) const {
        LAS float* P = (LAS float*)lds;
        const int row0 = u.pm * BM + wr * 64 + fr, col0 = u.pn * BM + wc * 32 + 8 * fq;
#pragma unroll
        for (int ai = 0; ai < 2; ++ai)
#pragma unroll
            for (int m = 0; m < 4; ++m) { ROWGROUP_BEGIN(r, row0 + ai * HALF + m * 16); float q = 0.f;
                float rs = 1.f; if (MODE == 1) rs = rstd_at(ssq_in, r);
#pragma unroll
                for (int bj = 0; bj < 2; ++bj) { const unsigned e = (unsigned)(r * DM + col0 + bj * HALF);
                    const f32x4 h0 = ldg<f32x4>(hin, e * 4u), h1 = ldg<f32x4>(hin, e * 4u + 16u);
                    f32x4 y0, y1;
                    if (MODE == 0) { y0 = h0 + acc[ai][bj][m][0] * scale; y1 = h1 + acc[ai][bj][m][1] * scale; }
                    else { f32x4 t0, t1; unpack8(ldg<u32x4>(T2, e * 2u), t0, t1);
#pragma unroll
                        for (int i = 0; i < 4; ++i) { y0[i] = h0[i] + sigmoidf_(acc[ai][bj][m][0][i] * rs) * t0[i]; y1[i] = h1[i] + sigmoidf_(acc[ai][bj][m][1][i] * rs) * t1[i]; } }
                    stg<f32x4>(hout, e * 4u, y0); stg<f32x4>(hout, e * 4u + 16u, y1);
                    stg<u32x4>(HB, e * 2u, pack8(y0, y1));
                    q += (y0[0] * y0[0] + y0[1] * y0[1]) + (y0[2] * y0[2] + y0[3] * y0[3]) + (y1[0] * y1[0] + y1[1] * y1[1]) + (y1[2] * y1[2] + y1[3] * y1[3]); }
                q += shx(q, 16, lane); q += shx(q, 32, lane);
                if (fq == 0) P[(ai * HALF + wr * 64 + m * 16 + fr) * 4 + wc] = q; }
        asm volatile("s_waitcnt lgkmcnt(0)" ::: "memory"); __builtin_amdgcn_s_barrier(); asm volatile("" ::: "memory");
        const int t = wid * 64 + lane;
        if (t < 256) { const f32x4 p = *(const LAS f32x4*)(P + 4 * t); ssq_out[(size_t)(u.pm * BM + t) * 4 + u.pn] = (p.x + p.y) + (p.z + p.w); }
        asm volatile("s_waitcnt lgkmcnt(0)" ::: "memory"); __builtin_amdgcn_s_barrier(); asm volatile("" ::: "memory");
    }
};
}

#include <hip/hip_bf16.h>
#include <cmath>
namespace moba {
using bf16=__hip_bfloat16;
using bf16x8=__attribute__((ext_vector_type(8)))short;
using s16x4=__attribute__((ext_vector_type(4)))short;
using f32x16=__attribute__((ext_vector_type(16)))float;
using u32x4=__attribute__((ext_vector_type(4)))unsigned;
constexpr int BATCH=4,NHEAD=8,SEQ=4096,D=64,DM=NHEAD*D;
constexpr int NW=8,QBLK=32,QB=QBLK*NW,KVBLK=64,NQB=SEQ/QB;
constexpr int ATTN_PITCH=DM, ATTN_UNIT_ROWS=QB;
__device__ __forceinline__ int crow(int r,int hi){return (r&3)+8*(r>>2)+4*hi;}
#define SBAR() __builtin_amdgcn_sched_barrier(0)
__device__ __forceinline__ void cmask(f32x16&p0,f32x16&p1,int jb,int qrel,int hi){
  const float NEG=-INFINITY; int kb=64*jb+4*hi;
  #pragma unroll
  for(int r=0;r<16;++r){int kv=kb+(r&3)+8*(r>>2); if(kv>qrel)p0[r]=NEG; if(kv+32>qrel)p1[r]=NEG;}
}

constexpr int NSLOT=3, SLOTB=8192;
constexpr int LDS_K=0, LDS_V=NSLOT*SLOTB, LDS_WS=2*NSLOT*SLOTB, LDS_OST=LDS_WS+NW*64*4, LDS_KS=LDS_OST+NW*4096, LDS_BYTES=LDS_KS+4096;
constexpr float C2=0.125f*1.4426950408889634f;
__device__ __forceinline__ void glds16(const void*gsrc,unsigned lds_dst){unsigned keep;
  asm volatile("s_mov_b32 %0, m0\n\ts_mov_b32 m0, %2\n\ts_nop 0\n\tglobal_load_lds_dwordx4 %1, off\n\ts_mov_b32 m0, %0":"=&s"(keep):"v"(gsrc),"s"(lds_dst):"memory");}
__device__ __forceinline__ float max3f(float a,float b,float c){float r;asm("v_max3_f32 %0, %1, %2, %3":"=v"(r):"v"(a),"v"(b),"v"(c));return r;}
__device__ __forceinline__ float max2f(float a,float b){float r;asm("v_max_f32_e32 %0, %1, %2":"=v"(r):"v"(a),"v"(b));return r;}
__device__ __forceinline__ float fadd_s(float a,float b){float r;asm("v_add_f32_e32 %0, %1, %2":"=v"(r):"v"(a),"v"(b));return r;}
__device__ __forceinline__ float fsub_s(float a,float b){float r;asm("v_sub_f32_e32 %0, %1, %2":"=v"(r):"v"(a),"v"(b));return r;}
typedef float f32x2_t __attribute__((ext_vector_type(2))); typedef __bf16 bf16x2_t __attribute__((ext_vector_type(2)));
__device__ __forceinline__ unsigned cvtpk_s(float lo,float hi){f32x2_t v={lo,hi};bf16x2_t b=__builtin_convertvector(v,bf16x2_t);return __builtin_bit_cast(unsigned,b);}
#define WAIT_BAR(N) asm volatile("s_waitcnt vmcnt(" #N ") lgkmcnt(0)\n\ts_barrier":::"memory")

__device__ __forceinline__ void qkt(f32x16&p0,f32x16&p1,const char*Kslot,const bf16x8*qr,int r32,int hi){
  const char*kb=Kslot+hi*1024+r32*16;
  #pragma unroll
  for(int d0=0;d0<4;++d0){
    const bf16x8 b0=*reinterpret_cast<const bf16x8*>(kb+d0*2048);
    const bf16x8 b1=*reinterpret_cast<const bf16x8*>(kb+d0*2048+512);
    if(d0==0){p0=__builtin_amdgcn_mfma_f32_32x32x16_bf16(b0,qr[0],f32x16{},0,0,0);p1=__builtin_amdgcn_mfma_f32_32x32x16_bf16(b1,qr[0],f32x16{},0,0,0);}
    else{p0=__builtin_amdgcn_mfma_f32_32x32x16_bf16(b0,qr[d0],p0,0,0,0);p1=__builtin_amdgcn_mfma_f32_32x32x16_bf16(b1,qr[d0],p1,0,0,0);}}
}
typedef __attribute__((address_space(3))) const char* lds_cptr;
typedef short v4i16_t __attribute__((ext_vector_type(4)));
__device__ __forceinline__ void kload8(bf16x8*kf,lds_cptr kp){
  kf[0]=*(const __attribute__((address_space(3))) bf16x8*)(kp);      kf[1]=*(const __attribute__((address_space(3))) bf16x8*)(kp+512);
  kf[2]=*(const __attribute__((address_space(3))) bf16x8*)(kp+2048); kf[3]=*(const __attribute__((address_space(3))) bf16x8*)(kp+2560);
  kf[4]=*(const __attribute__((address_space(3))) bf16x8*)(kp+4096); kf[5]=*(const __attribute__((address_space(3))) bf16x8*)(kp+4608);
  kf[6]=*(const __attribute__((address_space(3))) bf16x8*)(kp+6144); kf[7]=*(const __attribute__((address_space(3))) bf16x8*)(kp+6656);
}
__device__ __forceinline__ void kload2(bf16x8*kf,lds_cptr kp,int j){ kf[2*j]=*(const __attribute__((address_space(3))) bf16x8*)(kp+j*2048); kf[2*j+1]=*(const __attribute__((address_space(3))) bf16x8*)(kp+j*2048+512); }
__device__ __forceinline__ s16x4 vtr(lds_cptr p){ return __builtin_bit_cast(s16x4,__builtin_amdgcn_ds_read_tr16_b64_v4i16((__attribute__((address_space(3))) v4i16_t*)p)); }
__device__ __forceinline__ float rowmax(const f32x16&p0,const f32x16&p1){
  float a=max3f(p0[0],p0[1],p1[0]),b=max3f(p0[2],p0[3],p1[1]);a=max3f(a,p1[2],p1[3]);
  #pragma unroll
  for(int r=4;r<16;r+=4){a=max3f(a,p0[r],p0[r+1]);b=max3f(b,p0[r+2],p0[r+3]);a=max3f(a,p1[r],p1[r+1]);b=max3f(b,p1[r+2],p1[r+3]);}
  const float m=max2f(a,b);
  auto rr=__builtin_amdgcn_permlane32_swap(__float_as_uint(m),__float_as_uint(m),false,false);
  return max2f(__uint_as_float(rr[0]),__uint_as_float(rr[1]));
}
__device__ __forceinline__ void pv(f32x16*o,int vb,bf16x8 pa0,bf16x8 pa1,bf16x8 pa2,bf16x8 pa3){
  #pragma unroll
  for(int d0=0;d0<2;++d0){s16x4 lo[4],hi[4];
    #pragma unroll
    for(int ks=0;ks<4;++ks){
      asm volatile("ds_read_b64_tr_b16 %0,%1 offset:%c2":"=&v"(lo[ks]):"v"(vb),"i"(d0*4096+ks*1024):"memory");
      asm volatile("ds_read_b64_tr_b16 %0,%1 offset:%c2":"=&v"(hi[ks]):"v"(vb),"i"(d0*4096+ks*1024+512):"memory");}
    asm volatile("s_waitcnt lgkmcnt(0)":::"memory");SBAR();
    #define PK(k) (bf16x8){lo[k][0],lo[k][1],lo[k][2],lo[k][3],hi[k][0],hi[k][1],hi[k][2],hi[k][3]}
    o[d0]=__builtin_amdgcn_mfma_f32_32x32x16_bf16(pa0,PK(0),o[d0],0,0,0);
    o[d0]=__builtin_amdgcn_mfma_f32_32x32x16_bf16(pa1,PK(1),o[d0],0,0,0);
    o[d0]=__builtin_amdgcn_mfma_f32_32x32x16_bf16(pa2,PK(2),o[d0],0,0,0);
    o[d0]=__builtin_amdgcn_mfma_f32_32x32x16_bf16(pa3,PK(3),o[d0],0,0,0);
    #undef PK
  }
}

__device__ __forceinline__ void selmask(f32x16&p0,f32x16&p1,bool keep,float mhat){
  const float a=keep?-mhat:-INFINITY;
  #pragma unroll
  for(int r=0;r<16;++r){p0[r]+=a;p1[r]+=a;}
}
#ifndef ATTN_STORE16
#define ATTN_STORE16(p,v) (*(u32x4*)(p)=(v))
#endif
template<int THRL> __device__ __forceinline__ void attn_unit(int b,int h,int qb,const bf16*Q,const bf16*__restrict__ K,const bf16*__restrict__ V,bf16*O,const float*KSUM,char*shm,int wave_s){
  const int tid=tid_now(wave_s),lane=tid&63,r32=lane&31,hi=lane>>5; const int wid=wave_s;
  const long rowbase=(long)b*SEQ; const int q0=qb*QB;
  const bf16*Qw=Q+(rowbase+q0+wid*QBLK)*DM+h*D;
  const bf16*Kh=K+rowbase*DM+h*D,*Vh=V+rowbase*DM+h*D;
  const unsigned lds0=(unsigned)(uintptr_t)shm;
  float*wsf=(float*)(shm+LDS_WS)+wid*64;
  const bf16*ksrc=Kh+(long)lane*DM+wid*8;
  const bf16*vsrc=Vh+(long)(16*(wid&3)+(lane>>2))*DM+(wid>>2)*32+(lane&3)*8;
  const unsigned kdst=lds0+LDS_K+wid*1024, vdst=lds0+LDS_V+wid*1024;
  #define KT(t) (((t)<4)?(4*qb+(t)):((t)-4))
  #define DMA_K(t,slot) glds16(ksrc+(long)KT(t)*KVBLK*DM,(unsigned)__builtin_amdgcn_readfirstlane(kdst+(slot)))
  #define DMA_V(t,slot) glds16(vsrc+(long)KT(t)*KVBLK*DM,(unsigned)__builtin_amdgcn_readfirstlane(vdst+(slot)))
  const int vb0=(int)(lds0+LDS_V)+((lane>>4)&1)*32+(lane&3)*8+(4*hi+((lane&15)>>2))*64;
  const char*Kbase=shm+LDS_K; bf16x8 kf[8];
  const lds_cptr shm3=(lds_cptr)shm; const lds_cptr kp0=shm3+LDS_K+hi*1024+r32*16; const lds_cptr vp0=shm3+LDS_V+((lane>>4)&1)*32+(lane&3)*8+(4*hi+((lane&15)>>2))*64;
  const int NT=4*qb+4;
  DMA_K(0,0);DMA_V(0,0);DMA_K(1,SLOTB);
  bf16x8 qr[4];
  #pragma unroll
  for(int d0=0;d0<4;++d0)qr[d0]=*reinterpret_cast<const bf16x8*>(&Qw[(long)r32*DM+d0*16+hi*8]);
  { float*ksl=(float*)(shm+LDS_KS); const int n_=tid>>5,d2=(tid&31)*2; const float*kp=KSUM+((size_t)(b*16+n_)*2)*512+h*64+d2;
    typedef float f32x2_ __attribute__((ext_vector_type(2)));
    const f32x2_ a_=*(const f32x2_*)kp,c_=*(const f32x2_*)(kp+512); *(f32x2_*)(ksl+n_*64+d2)=a_+c_; }
  DMA_K(2,2*SLOTB);
  asm volatile("s_waitcnt lgkmcnt(0)\n\ts_barrier":::"memory");
  unsigned sel;
  { const lds_cptr ksp=shm3+LDS_KS+hi*32; float qf[32];
    #pragma unroll
    for(int d0=0;d0<4;++d0)
      #pragma unroll
      for(int j=0;j<8;++j)qf[8*d0+j]=__uint_as_float(((unsigned)(unsigned short)qr[d0][j])<<16);
    float v1=-INFINITY,v2=-INFINITY,v3=-INFINITY; int i1=31,i2=31,i3=31;
    #pragma unroll
    for(int n=0;n<16;++n){ float s=0.f;
      #pragma unroll
      for(int d0=0;d0<4;++d0){ typedef float f32x4_ __attribute__((ext_vector_type(4)));
        const f32x4_ k0=*(const __attribute__((address_space(3))) f32x4_*)(ksp+n*256+d0*64), k1=*(const __attribute__((address_space(3))) f32x4_*)(ksp+n*256+d0*64+16);
        s+=qf[8*d0]*k0.x+qf[8*d0+1]*k0.y+qf[8*d0+2]*k0.z+qf[8*d0+3]*k0.w+qf[8*d0+4]*k1.x+qf[8*d0+5]*k1.y+qf[8*d0+6]*k1.z+qf[8*d0+7]*k1.w; }
      { auto rr=__builtin_amdgcn_permlane32_swap(__float_as_uint(s),__float_as_uint(s),false,false); s=__uint_as_float(rr[0])+__uint_as_float(rr[1]); }
      s=(n<qb)?s:-INFINITY;
      if(s>v1){v3=v2;i3=i2;v2=v1;i2=i1;v1=s;i1=n;} else if(s>v2){v3=v2;i3=i2;v2=s;i2=n;} else if(s>v3){v3=s;i3=n;} }
    sel=(1u<<i1)|(1u<<i2)|(1u<<i3); }
  float mhat=0.f,l_reg=0.f;f32x16 o[2];o[0]=f32x16{};o[1]=f32x16{};
  const int qrel=wid*QBLK+r32;
  #define CMASK(P0,P1,t) do{ if((t)<4){cmask(P0,P1,(t),qrel,hi);selmask(P0,P1,true,mhat);} else selmask(P0,P1,((sel>>(((t)-4)>>2))&1u)!=0u,mhat); }while(0)
  bool resc=false;
  #define START(P0,P1) do{ const float rm=rowmax(P0,P1); resc=false; \
    { const float dl=rm; mhat=fadd_s(mhat,dl); \
      _Pragma("unroll") for(int r=0;r<16;++r){P0[r]=fsub_s(P0[r],dl);P1[r]=fsub_s(P1[r],dl);} \
      } \
    _Pragma("unroll") for(int r=0;r<16;++r)P0[r]=__builtin_amdgcn_exp2f(P0[r]); }while(0)
  #define RESC() do{ if(resc){ asm volatile("s_waitcnt lgkmcnt(0)":::"memory"); \
      _Pragma("unroll") for(int d_=0;d_<2;++d_) _Pragma("unroll") for(int r=0;r<16;++r)o[d_][r]*=wsf[crow(r,hi)]; } }while(0)
  f32x16 pA0,pA1,pB0,pB1;
  int sl_prev=0,sl_cur=0,sl_next=SLOTB;
  #define ROT() do{sl_prev=sl_cur;sl_cur=sl_next;sl_next=(sl_next==(NSLOT-1)*SLOTB)?0:sl_next+SLOTB;}while(0)
  WAIT_BAR(3);
  qkt(pA0,pA1,Kbase,qr,r32,hi);asm volatile("s_nop 15\n\ts_nop 7":"+v"(pA0),"+v"(pA1));cmask(pA0,pA1,0,qrel,hi);
  START(pA0,pA1);
  _Pragma("unroll") for(int r=0;r<16;++r)pA1[r]=__builtin_amdgcn_exp2f(pA1[r]);
  WAIT_BAR(0);
  DMA_K(3,0);DMA_V(1,SLOTB);
  ROT();
  kload8(kf,kp0+sl_cur);
  WAIT_BAR(2);
  s16x4 vlo[8],vhi[8]; u32x4 pw0,pw1,pw2,pw3;
  #define PKW(P,B) cvtpk_s(P[B],P[B+1])
  #define PAF(k) __builtin_bit_cast(bf16x8,pw##k)
  #define VFR(i) (bf16x8){vlo[i][0],vlo[i][1],vlo[i][2],vlo[i][3],vhi[i][0],vhi[i][1],vhi[i][2],vhi[i][3]}
  #define PIN(x) asm volatile("":"+v"(x))
  #define MX3(a,b,c) __builtin_fmaxf(__builtin_fmaxf((a),(b)),(c))
  #define GAPA(MF,A0,A1,A2,A3,W0,W1,PW) do{ MF; sacc+=A0; sacc+=A1; sacc+=A2; sacc+=A3; PIN(sacc); W0; W1; PIN(PW); SBAR(); }while(0)
  #define EX(v) __builtin_amdgcn_exp2f(v)
  #define GAPB(MF,X,B) do{ MF; X[B]=EX(X[B]); X[B+1]=EX(X[B+1]); X[B+2]=EX(X[B+2]); X[B+3]=EX(X[B+3]); PIN(X); SBAR(); }while(0)
  #define VRD(i) do{ vlo[i]=vtr(vp_+(((i)>>2)*4096+((i)&3)*1024)); vhi[i]=vtr(vp_+(((i)>>2)*4096+((i)&3)*1024+512)); }while(0)
  #define KRD(G,j) do{ if(G){ kload2(kf,kp0+sl_next,j); SBAR(); } }while(0)
  #define STEP(C0,C1,P0,P1,t,GK,GV,GL) do{ SBAR(); \
    const lds_cptr vp_=vp0+sl_prev; \
    VRD(0); SBAR(); float sacc=(P0[0]+P0[1]); \
    GAPA(C0=__builtin_amdgcn_mfma_f32_32x32x16_bf16(kf[0],qr[0],f32x16{},0,0,0), P0[2],P0[3],P0[4],P0[5],     pw0[0]=PKW(P0,0), pw0[1]=PKW(P0,2), pw0); \
    VRD(4); SBAR(); GAPA(C1=__builtin_amdgcn_mfma_f32_32x32x16_bf16(kf[1],qr[0],f32x16{},0,0,0), P0[6],P0[7],P0[8],P0[9],     pw0[2]=PKW(P0,4), pw0[3]=PKW(P0,6), pw0); \
    VRD(1); SBAR(); GAPA(C0=__builtin_amdgcn_mfma_f32_32x32x16_bf16(kf[2],qr[1],C0,0,0,0),   P0[10],P0[11],P0[12],P0[13], pw1[0]=PKW(P0,8), pw1[1]=PKW(P0,10), pw1); \
    VRD(5); SBAR(); GAPA(C1=__builtin_amdgcn_mfma_f32_32x32x16_bf16(kf[3],qr[1],C1,0,0,0),   P0[14],P0[15],P1[0],P1[1],   pw1[2]=PKW(P0,12),pw1[3]=PKW(P0,14), pw1); \
    VRD(2); SBAR(); GAPA(C0=__builtin_amdgcn_mfma_f32_32x32x16_bf16(kf[4],qr[2],C0,0,0,0),   P1[2],P1[3],P1[4],P1[5],     pw2[0]=PKW(P1,0), pw2[1]=PKW(P1,2), pw2); \
    VRD(6); SBAR(); GAPA(C1=__builtin_amdgcn_mfma_f32_32x32x16_bf16(kf[5],qr[2],C1,0,0,0),   P1[6],P1[7],P1[8],P1[9],     pw2[2]=PKW(P1,4), pw2[3]=PKW(P1,6), pw2); \
    VRD(3); SBAR(); GAPA(C0=__builtin_amdgcn_mfma_f32_32x32x16_bf16(kf[6],qr[3],C0,0,0,0),   P1[10],P1[11],P1[12],P1[13], pw3[0]=PKW(P1,8), pw3[1]=PKW(P1,10), pw3); \
    VRD(7); SBAR(); GAPA(C1=__builtin_amdgcn_mfma_f32_32x32x16_bf16(kf[7],qr[3],C1,0,0,0),   P1[14],P1[15],0.f,0.f,       pw3[2]=PKW(P1,12),pw3[3]=PKW(P1,14), pw3); \
    l_reg+=sacc; \
    if(GK){DMA_K((t)+3,sl_cur);} if(GV){DMA_V((t)+1,sl_next);} \
    CMASK(C0,C1,t); \
    { float a=MX3(C0[0],C0[1],C1[0]),b=MX3(C0[2],C0[3],C1[1]); a=MX3(a,C1[2],C1[3]); \
      _Pragma("unroll") for(int r=4;r<16;r+=4){a=MX3(a,C0[r],C0[r+1]);b=MX3(b,C0[r+2],C0[r+3]);a=MX3(a,C1[r],C1[r+1]);b=MX3(b,C1[r+2],C1[r+3]);} \
      float rm=__builtin_fmaxf(a,b); { auto rr=__builtin_amdgcn_permlane32_swap(__float_as_uint(rm),__float_as_uint(rm),false,false); rm=__builtin_fmaxf(__uint_as_float(rr[0]),__uint_as_float(rr[1])); } \
      resc=false; \
      if(__builtin_expect(__any(rm>(float)THRL),0)){ const float dl=__builtin_fmaxf(rm,0.f); mhat+=dl; \
        _Pragma("unroll") for(int r=0;r<16;++r){C0[r]-=dl;C1[r]-=dl;} \
        const float f=__builtin_amdgcn_exp2f(-dl); l_reg*=f; if(hi==0)wsf[r32]=f; resc=true; } } \
    SBAR(); \
    GAPB(o[0]=__builtin_amdgcn_mfma_f32_32x32x16_bf16(PAF(0),VFR(0),o[0],0,0,0), C0,0); \
    GAPB(o[1]=__builtin_amdgcn_mfma_f32_32x32x16_bf16(PAF(0),VFR(4),o[1],0,0,0), C0,4); \
    KRD(GL,0); GAPB(o[0]=__builtin_amdgcn_mfma_f32_32x32x16_bf16(PAF(1),VFR(1),o[0],0,0,0), C0,8); \
    KRD(GL,1); GAPB(o[1]=__builtin_amdgcn_mfma_f32_32x32x16_bf16(PAF(1),VFR(5),o[1],0,0,0), C0,12); \
    KRD(GL,2); GAPB(o[0]=__builtin_amdgcn_mfma_f32_32x32x16_bf16(PAF(2),VFR(2),o[0],0,0,0), C1,0); \
    KRD(GL,3); GAPB(o[1]=__builtin_amdgcn_mfma_f32_32x32x16_bf16(PAF(2),VFR(6),o[1],0,0,0), C1,4); \
    GAPB(o[0]=__builtin_amdgcn_mfma_f32_32x32x16_bf16(PAF(3),VFR(3),o[0],0,0,0), C1,8); \
    GAPB(o[1]=__builtin_amdgcn_mfma_f32_32x32x16_bf16(PAF(3),VFR(7),o[1],0,0,0), C1,12); \
    }while(0)
  int t=1;
  #define ENDW(tt) do{ if((tt)+3<NT){WAIT_BAR(2);} else if((tt)+2<NT){WAIT_BAR(1);} else {WAIT_BAR(0);} }while(0)
  for(;t<5&&t+1<NT;t+=2){
    STEP(pB0,pB1,pA0,pA1,t,(t+3<NT),(t+1<NT),(t+1<NT));       ENDW(t);   RESC(); ROT();
    STEP(pA0,pA1,pB0,pB1,t+1,(t+4<NT),(t+2<NT),(t+2<NT));     ENDW(t+1); RESC(); ROT();
  }
  #undef CMASK
  #define CMASK(P0,P1,t) selmask(P0,P1,((sel>>(((t)-4)>>2))&1u)!=0u,mhat)
  for(;t+5<NT;t+=2){
    STEP(pB0,pB1,pA0,pA1,t,true,true,true);     WAIT_BAR(2); RESC(); ROT();
    STEP(pA0,pA1,pB0,pB1,t+1,true,true,true);   WAIT_BAR(2); RESC(); ROT();
  }
  for(;t+1<NT;t+=2){
    STEP(pB0,pB1,pA0,pA1,t,(t+3<NT),(t+1<NT),(t+1<NT));       ENDW(t);   RESC(); ROT();
    STEP(pA0,pA1,pB0,pB1,t+1,(t+4<NT),(t+2<NT),(t+2<NT));     ENDW(t+1); RESC(); ROT();
  }
  #undef CMASK
  #define CMASK(P0,P1,t) do{ if((t)<4){cmask(P0,P1,(t),qrel,hi);selmask(P0,P1,true,mhat);} else selmask(P0,P1,((sel>>(((t)-4)>>2))&1u)!=0u,mhat); }while(0)
  STEP(pB0,pB1,pA0,pA1,NT-1,false,false,false); RESC();
  { float sacc=pB0[0]+pB0[1]; _Pragma("unroll") for(int r=2;r<16;++r)sacc+=pB0[r]; _Pragma("unroll") for(int r=0;r<16;++r)sacc+=pB1[r]; l_reg+=sacc;
    pw0=(u32x4){PKW(pB0,0),PKW(pB0,2),PKW(pB0,4),PKW(pB0,6)};pw1=(u32x4){PKW(pB0,8),PKW(pB0,10),PKW(pB0,12),PKW(pB0,14)};pw2=(u32x4){PKW(pB1,0),PKW(pB1,2),PKW(pB1,4),PKW(pB1,6)};pw3=(u32x4){PKW(pB1,8),PKW(pB1,10),PKW(pB1,12),PKW(pB1,14)};
    SBAR(); pv(o,vb0+sl_cur,PAF(0),PAF(1),PAF(2),PAF(3)); }
  #undef PKW
  #undef PAF
  #undef VFR
  #undef PIN
  #undef MX3
  #undef GAPA
  #undef GAPB
  #undef EX
  #undef VRD
  #undef KRD
  #undef STEP
  #undef ENDW
  {auto rr=__builtin_amdgcn_permlane32_swap(__float_as_uint(l_reg),__float_as_uint(l_reg),false,false);l_reg=__uint_as_float(rr[0])+__uint_as_float(rr[1]);}
  if(hi==0)wsf[32+r32]=l_reg;asm volatile("s_waitcnt lgkmcnt(0)":::"memory");
  float rli[16];
  #pragma unroll
  for(int r=0;r<16;++r)rli[r]=__builtin_amdgcn_rcpf(wsf[32+crow(r,hi)]);
  bf16*Ow=O+(rowbase+q0+wid*QBLK)*DM+h*D;
  { bf16*stg=(bf16*)(shm+LDS_OST)+wid*2048;
    #pragma unroll
    for(int r=0;r<16;++r){const int orow=crow(r,hi);
      #pragma unroll
      for(int d0=0;d0<2;++d0)stg[orow*64+d0*32+r32]=__float2bfloat16(o[d0][r]*rli[r]);}
    asm volatile("s_waitcnt lgkmcnt(0)":::"memory");
    #pragma unroll
    for(int i=0;i<4;++i){const int row=i*8+(lane>>3),ch=lane&7; const u32x4 v=*(const u32x4*)(stg+row*64+ch*8); ATTN_STORE16(Ow+(long)row*DM+ch*8,v);} }
  asm volatile("s_waitcnt lgkmcnt(0)\n\ts_barrier":::"memory");
  #undef DMA_K
  #undef DMA_V
  #undef KT
  #undef CMASK
  #undef START
  #undef RESC
  #undef ROT
}
constexpr int ATTN_LDS_BYTES=LDS_BYTES;
template<int THRL=8> __device__ __forceinline__ void attn_phase(char*lds,const bf16*Q,const bf16*K,const bf16*V,bf16*O,const float*KSUM,int vcu,int G,int wave_s){
  for(int p=vcu;p<BATCH*NHEAD*8;p+=G){
    #pragma unroll 1
    for(int k=0;k<2;++k){ const int bh=p>>3,s=p&7,qb=k?s:15-s; attn_unit<THRL>(bh>>3,bh&7,qb,Q,K,V,O,KSUM,lds,wave_s); }
  }
}
#undef SBAR
#undef WAIT_BAR
}

__device__ __forceinline__ float wave_sum(float v, int lane) {
#pragma unroll
    for (int o = 1; o < 64; o <<= 1) v += shx(v, o, lane);
    return v;
}
__device__ __forceinline__ void transpose_item(const float* W, int Ksrc, int Nsrc, const float* gain, bf16_t* WT, int k0, int n0, int drow0, LAS float* scr, int lane) {
#pragma unroll 8
    for (int i = 0; i < 32; ++i) { const int kk = 2 * i + (lane >> 5); float v = W[(size_t)(k0 + kk) * Nsrc + n0 + (lane & 31)]; if (gain) v *= gain[k0 + kk]; scr[kk * 33 + (lane & 31)] = v; }
    LDS_WAIT(); asm volatile("" ::: "memory");
    const int c = lane & 7;
#pragma unroll
    for (int j = 0; j < 4; ++j) { const int n = (lane >> 3) + 8 * j; const LAS float* s = scr + (8 * c) * 33 + n;
        u32x4 o; o.x = pk2(s[0 * 33], s[1 * 33]); o.y = pk2(s[2 * 33], s[3 * 33]); o.z = pk2(s[4 * 33], s[5 * 33]); o.w = pk2(s[6 * 33], s[7 * 33]);
        *(u32x4*)(WT + (size_t)(drow0 + n) * Ksrc + k0 + 8 * c) = o; }
    LDS_WAIT(); asm volatile("" ::: "memory");
}
__device__ __forceinline__ int win_drow(int c) {
    if (c < 512) return c;
    if (c < 1024) { const int ch = c - 512; return 512 + (ch >> 7) * 256 + (ch & 127); }
    if (c < 1536) { const int ch = c - 1024; return 512 + (ch >> 7) * 256 + 128 + (ch & 127); }
    if (c < 2560) { const int base = c < 2048 ? 1536 : 2048; const int cq = c - base, head = cq >> 6, half = (cq >> 5) & 1; return base + (head >> 2) * 256 + half * 128 + (head & 3) * 32; }
    return c;
}
__device__ __forceinline__ int gu_drow(int c, int isup) { return (c >> 7) * 256 + isup * 128 + (c & 127); }

struct Args { const float* in[21]; float* out; unsigned char* ws; int ph_lo, ph_hi; };

constexpr int TBL_OFF = MISC_OFF + 128;
__device__ __forceinline__ const float* in_ptr(LAS unsigned char* lds, int k) {
    const LAS unsigned* t = (const LAS unsigned*)(lds + TBL_OFF) + 2 * k; unsigned lo = t[0], hi = t[1];
    lo = __builtin_amdgcn_readfirstlane(lo); hi = __builtin_amdgcn_readfirstlane(hi);
    return (const float*)(GAS const float*)(((unsigned long long)hi << 32) | lo);
}
__device__ __forceinline__ unsigned char* launder(unsigned char* p) { size_t z = 0; asm volatile("" : "+s"(z)); return p + z; }

constexpr int I_GU = 16 * 88, I_D = 44 * 32, I_IN = 16 * 160, I_C = 8 * 32, I_O = 16 * 32, I_PP = 4 * 32;
constexpr int ITEMS_L = 6 * I_GU + I_IN + 2 * I_C + 2 * I_O + I_PP;
static_assert(I_GU == I_D && ITEMS_L == 12672, "item counts");

__device__ __forceinline__ void p0_weights(LAS unsigned char* lds, bf16_t* Wb, LAS float* scr, int gw, int NGW, int lane) {
    for (int gi = gw; gi < 2 * ITEMS_L; gi += NGW) {
        const int L = gi >= ITEMS_L ? 1 : 0; int r = gi - L * ITEMS_L; bf16_t* WL = Wb + (size_t)L * WL_ELEMS;
        if (r < 4 * I_GU) { const int which = r / I_GU; r -= which * I_GU; const int kb = r / 88, nb = r % 88; const int ffn = which >> 1, isup = which & 1;
            const float* src = in_ptr(lds, (ffn ? 11 : 8) + isup) + (size_t)L * DM * FF; const float* gn = in_ptr(lds, ffn ? 16 : 14) + L * DM;
            transpose_item(src, DM, FF, gn, WL + (ffn ? WO_GU2 : WO_GU1), 64 * kb, 32 * nb, gu_drow(32 * nb, isup), scr, lane); continue; }
        r -= 4 * I_GU;
        if (r < 2 * I_D) { const int ffn = r / I_D; r -= ffn * I_D; const int kb = r / 32, nb = r % 32;
            transpose_item(in_ptr(lds, ffn ? 13 : 10) + (size_t)L * FF * DM, FF, DM, nullptr, WL + (ffn ? WO_D2 : WO_D1), 64 * kb, 32 * nb, 32 * nb, scr, lane); continue; }
        r -= 2 * I_D;
        if (r < I_IN) { const int kb = r / 160, nb = r % 160;
            transpose_item(in_ptr(lds, 3) + (size_t)L * DM * NIN, DM, NIN, in_ptr(lds, 15) + L * DM, WL + WO_IN, 64 * kb, 32 * nb, win_drow(32 * nb), scr, lane); continue; }
        r -= I_IN;
        if (r < 2 * I_C) { const int which = r / I_C; r -= which * I_C; const int kb = r / 32, nb = r % 32;
            transpose_item(in_ptr(lds, 5 + which) + (size_t)L * CW * DM, CW, DM, nullptr, WL + (which ? WO_A : WO_C), 64 * kb, 32 * nb, 32 * nb, scr, lane); continue; }
        r -= 2 * I_C;
        if (r < 2 * I_O) { const int which = r / I_O; r -= which * I_O; const int kb = r / 32, nb = r % 32;
            const float* gn = which ? in_ptr(lds, 17) + L * DM : nullptr;
            transpose_item(in_ptr(lds, which ? 18 : 7) + (size_t)L * DM * DM, DM, DM, gn, WL + (which ? WO_PG : WO_O), 64 * kb, 32 * nb, 32 * nb, scr, lane); continue; }
        r -= 2 * I_O;
        { const int kb = r / 32, nb = r % 32;
            transpose_item(in_ptr(lds, 19) + (size_t)L * PLED * DM, PLED, DM, nullptr, WL + WO_PP, 64 * kb, 32 * nb, 32 * nb, scr, lane); }
    }
}
__device__ __forceinline__ void p0_rows(const float* x, const int* pos, bf16_t* HB, float* ssq0, float* rcos, float* rsin, int gw, int NGW, int lane) {
    for (int m = gw; m < M; m += NGW) {
        const f32x4* xr = (const f32x4*)(x + (size_t)m * DM) + lane; f32x4 v[4]; float s = 0.f;
#pragma unroll
        for (int j = 0; j < 4; ++j) { v[j] = xr[64 * j]; s += (v[j].x * v[j].x + v[j].y * v[j].y) + (v[j].z * v[j].z + v[j].w * v[j].w); }
        s = wave_sum(s, lane);
        u32x2* o8 = (u32x2*)(HB + (size_t)m * DM) + lane;
#pragma unroll
        for (int j = 0; j < 4; ++j) { u32x2 w; w.x = pk2(v[j].x, v[j].y); w.y = pk2(v[j].z, v[j].w); o8[64 * j] = w; }
        if (lane == 0) *(f32x4*)(ssq0 + 4 * (size_t)m) = (f32x4){s, 0.f, 0.f, 0.f};
        if (lane < 32) { const float p = (float)pos[m]; const float invf = exp2f(-(float)lane * (13.287712379549449f / 32.0f)); const float ang = p * invf; float sn, cs; sincosf(ang, &sn, &cs);
            rcos[(size_t)m * 32 + lane] = cs; rsin[(size_t)m * 32 + lane] = sn; }
    }
}
__device__ __forceinline__ void pb_convert(const float* p, bf16_t* PB, int gw, int NGW, int lane) {
    for (int m = gw; m < M; m += NGW) { const f32x4 v = *((const f32x4*)(p + (size_t)m * PLED) + lane); u32x2 w; w.x = pk2(v.x, v.y); w.y = pk2(v.z, v.w); *((u32x2*)(PB + (size_t)m * PLED) + lane) = w; }
}
__device__ __forceinline__ void convmix(const bf16_t* BG, const bf16_t* U, const float* cwt, bf16_t* CM, int gt, int NGT) {
    for (int e = gt; e < M * (CW / 8); e += NGT) { const int r = e >> 6, c8 = (e & 63) * 8, s = r & (SEQ - 1);
        const u32x4 b = *(const u32x4*)(BG + (size_t)r * CW + c8), u0 = *(const u32x4*)(U + (size_t)r * CW + c8);
        u32x4 u1 = (u32x4){0u, 0u, 0u, 0u}, u2 = (u32x4){0u, 0u, 0u, 0u};
        if (s >= 1) u1 = *(const u32x4*)(U + (size_t)(r - 1) * CW + c8);
        if (s >= 2) u2 = *(const u32x4*)(U + (size_t)(r - 2) * CW + c8);
        float o[8];
#pragma unroll
        for (int j = 0; j < 4; ++j) { const unsigned bw = b[j], w0 = u0[j], w1 = u1[j], w2 = u2[j]; const int c = c8 + 2 * j;
            o[2 * j] = bf_lo(bw) * (cwt[c] * bf_lo(w2) + cwt[CW + c] * bf_lo(w1) + cwt[2 * CW + c] * bf_lo(w0));
            o[2 * j + 1] = bf_hi(bw) * (cwt[c + 1] * bf_hi(w2) + cwt[CW + c + 1] * bf_hi(w1) + cwt[2 * CW + c + 1] * bf_hi(w0)); }
        u32x4 w; w.x = pk2(o[0], o[1]); w.y = pk2(o[2], o[3]); w.z = pk2(o[4], o[5]); w.w = pk2(o[6], o[7]);
        *(u32x4*)(CM + (size_t)r * CW + c8) = w; }
}
__device__ __forceinline__ void final_norm(float* h, const float* ssq, const float* g, int gw, int NGW, int lane) {
    for (int m = gw; m < M; m += NGW) { const float rs = rstd_of(ssq, m); f32x4* hr = (f32x4*)(h + (size_t)m * DM) + lane; const f32x4* gr = (const f32x4*)g + lane;
#pragma unroll
        for (int j = 0; j < 4; ++j) { const f32x4 v = hr[64 * j], gg = gr[64 * j]; hr[64 * j] = v * rs * gg; } }
}

#define XB_TMO      128
#define XB_XCNT(j)  (256  + 64 * (j))
#define XB_XSUB(j)  (1280 + 64 * (j))
#define XB_XGEN(j)  (2304 + 64 * (j))
#define XB_TOP      3328
#define XB_TOPGEN   3392
#define XCD_BAR_WORDS 3456
#define XB_SPIN_CAP (1u << 22)
constexpr int CW_BAR = 4096;
__device__ __forceinline__ unsigned xb_ld(unsigned* p)              { return __hip_atomic_load(p, __ATOMIC_RELAXED, __HIP_MEMORY_SCOPE_AGENT); }
__device__ __forceinline__ unsigned xb_add(unsigned* p, unsigned v) { return __hip_atomic_fetch_add(p, v, __ATOMIC_RELAXED, __HIP_MEMORY_SCOPE_AGENT); }
__device__ __forceinline__ unsigned xb_xcc_id() { return (unsigned)__builtin_amdgcn_s_getreg((3 << 11) | 20) & 0xFu; }
#define XB_SPIN(cond, bar) do { unsigned _sp = 0; while (cond) { __builtin_amdgcn_s_sleep(1); \
    if ((++_sp & 255u) == 0u) { if (xb_ld(&(bar)[XB_TMO])) break; if (_sp > XB_SPIN_CAP) { atomicAdd(&(bar)[XB_TMO], 1u); break; } } } } while (0)
__device__ __forceinline__ void xcd_barrier_complete(unsigned* bar, unsigned x, unsigned& nloc, unsigned& nx) {
    const unsigned G = gridDim.x * gridDim.y * gridDim.z;
    unsigned sum, cnt, mine, sp = 0u;
    for (;;) {
        sum = 0u; cnt = 0u; mine = 0u;
#pragma unroll
        for (unsigned j = 0; j < 16; ++j) { const unsigned c = xb_ld(&bar[XB_XCNT(j)]); sum += c; cnt += (c > 0u) ? 1u : 0u; mine = (j == x) ? c : mine; }
        if (sum == G) break;
        __builtin_amdgcn_s_sleep(1);
        if ((++sp & 255u) == 0u) { if (xb_ld(&bar[XB_TMO])) break; if (sp > XB_SPIN_CAP) { atomicAdd(&bar[XB_TMO], 1u); break; } }
    }
    nloc = mine > 0u ? mine : 1u; nx = cnt > 0u ? cnt : 1u;
}
__device__ __forceinline__ void xcd_barrier(unsigned* bar, unsigned x, volatile LAS unsigned* st, bool leader_thread) {
    asm volatile("s_waitcnt vmcnt(0)" ::: "memory");
    __syncthreads();
    if (leader_thread) {
        __builtin_amdgcn_s_waitcnt(0);
        unsigned nloc = st[0], nx = st[1];
        if (nloc == 0u) { xcd_barrier_complete(bar, x, nloc, nx); st[0] = nloc; st[1] = nx; }
        const unsigned old = xb_add(&bar[XB_XSUB(x)], 1u);
        const unsigned gen = old / nloc;
        if (old + 1u == (gen + 1u) * nloc) {
            __builtin_amdgcn_fence(__ATOMIC_RELEASE, "agent");
            asm volatile("s_waitcnt vmcnt(0)" ::: "memory");
            const unsigned og = xb_add(&bar[XB_TOP], 1u);
            const unsigned tg = og / nx;
            if (og + 1u == (tg + 1u) * nx) xb_add(&bar[XB_TOPGEN], 1u);
            else XB_SPIN(xb_ld(&bar[XB_TOPGEN]) == tg, bar);
            __builtin_amdgcn_fence(__ATOMIC_ACQUIRE, "agent");
            xb_add(&bar[XB_XGEN(x)], 1u);
            asm volatile("s_waitcnt vmcnt(0)" ::: "memory");
        } else {
            XB_SPIN(xb_ld(&bar[XB_XGEN(x)]) == gen, bar);
            __builtin_amdgcn_fence(__ATOMIC_ACQUIRE, "agent");
            asm volatile("s_waitcnt vmcnt(0)" ::: "memory");
        }
    }
    __syncthreads();
}

constexpr int NPHASE = 20;
#ifndef KMASK
#define KMASK 0x3FF
#endif
#define KIND(j) ((KMASK >> (j)) & 1)
__global__ void __launch_bounds__(NWAVES * 64, 2) skel_fwd(Args args) {
    extern __shared__ __attribute__((aligned(16))) unsigned char lds_raw[];
    LAS unsigned char* lds = (LAS unsigned char*)lds_raw;
    const int wave_s = __builtin_amdgcn_readfirstlane(threadIdx.x >> 6);
    {
        const int t0 = threadIdx.x;
        for (int u = t0; u < (LDS_BYTES - LDSCTL_OFF) / 4; u += NWAVES * 64) ((LAS unsigned*)(lds + LDSCTL_OFF))[u] = 0u;
        __syncthreads();
        if (t0 == 0) { LAS unsigned long long* t = (LAS unsigned long long*)(lds + TBL_OFF);
#pragma unroll
            for (int i = 0; i < 21; ++i) t[i] = (unsigned long long)args.in[i]; }
        __syncthreads();
    }
#if MK_ONE_LAUNCH
    const unsigned xcc = xb_xcc_id();
    if (threadIdx.x == 0) (void)xb_add((unsigned*)(args.ws + WS_CTL) + CW_BAR + XB_XCNT(xcc), 1u);
#endif
    for (int ph = args.ph_lo; ph < args.ph_hi; ++ph) {
        unsigned char* ws = launder(args.ws);
        int bx_ = blockIdx.x, G_ = gridDim.x; asm volatile("" : "+s"(bx_), "+s"(G_));
        const int G = G_, bx = bx_, vcu = (G % 8 == 0) ? (bx % 8) * (G / 8) + bx / 8 : bx, NGW = G * NWAVES;
        const int wave = wave_s, gw = vcu * NWAVES + wave;
#define TID_LANE const int tid = tid_now(wave_s), lane = tid & 63
        const int L = (ph - 1) / 9, j = (ph == 0) ? -1 : (ph == NPHASE - 1) ? 9 : (ph - 1) % 9;
        bf16_t* HB = (bf16_t*)(ws + WS_HB); unsigned char* X = ws + WS_X;
        const bf16_t* WL = (const bf16_t*)(ws + WS_W) + (size_t)L * WL_ELEMS;
        float *ssq0 = (float*)(ws + WS_SSQ0), *ssq1 = (float*)(ws + WS_SSQ1);
        if (KIND(0) && j == -1) { TID_LANE;
            p0_weights(lds, (bf16_t*)(ws + WS_W), (LAS float*)(lds + wave * 16384), gw, NGW, lane);
            p0_rows(in_ptr(lds, 0), (const int*)in_ptr(lds, 2), HB, ssq0, (float*)(ws + WS_COS), (float*)(ws + WS_SIN), gw, NGW, lane);
        } else if (KIND(1) && (j == 0 || j == 6)) {
            pg8::Gemm g{HB, WL + (j ? WO_GU2 : WO_GU1), nullptr, nullptr, DM}; pg8::StaticOrder S; S.init(M, NGU, G, bx);
            pg8::EpiSwiglu E{(bf16_t*)(X + X_ACT), ssq0};
            pg8::gemm_phase<pg8::EpiSwiglu, pg8::StaticOrder, true>(lds, g, S, E, wave_s);
        } else if (KIND(2) && (j == 1 || j == 7)) {
            const float* hin = (ph == 2) ? in_ptr(lds, 0) : args.out;
            { pg8::Gemm g{(const bf16_t*)(X + X_ACT), WL + (j == 7 ? WO_D2 : WO_D1), nullptr, nullptr, FF}; pg8::StaticOrder S; S.init(M, DM, G, bx);
              pg8::EpiRes<0> E{hin, args.out, HB, ssq1, 0.5f, nullptr, nullptr};
              pg8::gemm_phase<pg8::EpiRes<0>, pg8::StaticOrder, false>(lds, g, S, E, wave_s); }
            if (j == 7) { pg8::Gemm g2{(const bf16_t*)(X + X_PB), WL + WO_PP, nullptr, nullptr, PLED}; pg8::StaticOrder S2; S2.init(M, DM, G, bx);
              pg8::EpiPlain E2{(bf16_t*)(X + X_T2), DM};
              pg8::gemm_phase<pg8::EpiPlain, pg8::StaticOrder, true>(lds, g2, S2, E2, wave_s); }
        } else if (KIND(3) && j == 2) {
            pg8::Gemm g{HB, WL + WO_IN, nullptr, nullptr, DM}; pg8::StaticOrder S; S.init(M, NIN, G, bx);
            pg8::EpiWin E{ws, ssq1};
            pg8::gemm_phase<pg8::EpiWin, pg8::StaticOrder, true>(lds, g, S, E, wave_s);
        } else if (KIND(4) && j == 3) { TID_LANE;
            bf16_t* Qb = (bf16_t*)(X + X_Q);
            moba::attn_phase<8>((char*)lds_raw, (const moba::bf16*)Qb, (const moba::bf16*)(X + X_K), (const moba::bf16*)(X + X_V), (moba::bf16*)Qb, (const float*)(ws + WS_KSUM), vcu, G, wave_s);
            convmix((const bf16_t*)(X + X_BG), (const bf16_t*)(X + X_U), in_ptr(lds, 4) + (size_t)L * 3 * CW, HB  , vcu * NWAVES * 64 + tid, NGW * 64);
        } else if (KIND(5) && j == 4) {
            pg8::Gemm g{HB  , WL + WO_C, (const bf16_t*)(X + X_Q)  , WL + WO_A, CW}; pg8::TwoSegOrder S; S.so.init(M, DM, G, bx);
            pg8::EpiMerge E{(const bf16_t*)(X + X_SGC), (const bf16_t*)(X + X_SGA), (bf16_t*)(X + X_MERGED)};
            pg8::gemm_phase<pg8::EpiMerge, pg8::TwoSegOrder, true>(lds, g, S, E, wave_s);
        } else if (KIND(6) && j == 5) {
            { pg8::Gemm g{(const bf16_t*)(X + X_MERGED), WL + WO_O, nullptr, nullptr, DM}; pg8::StaticOrder S; S.init(M, DM, G, bx);
              pg8::EpiRes<0> E{args.out, args.out, HB, ssq0, 1.0f, nullptr, nullptr};
              pg8::gemm_phase<pg8::EpiRes<0>, pg8::StaticOrder, false>(lds, g, S, E, wave_s); }
            TID_LANE; pb_convert(in_ptr(lds, 1) + (size_t)L * M * PLED, (bf16_t*)(X + X_PB), gw, NGW, lane);
        } else if (KIND(7) && j == 8) {
            pg8::Gemm g{HB, WL + WO_PG, nullptr, nullptr, DM}; pg8::StaticOrder S; S.init(M, DM, G, bx);
            pg8::EpiRes<1> E{args.out, args.out, HB, ssq0, 1.0f, ssq1, (const bf16_t*)(X + X_T2)};
            pg8::gemm_phase<pg8::EpiRes<1>, pg8::StaticOrder, false>(lds, g, S, E, wave_s);
        } else if (KIND(8) && j == 9) { TID_LANE;
            final_norm(args.out, ssq0, in_ptr(lds, 20), gw, NGW, lane);
        }
#if MK_ONE_LAUNCH
        if (ph + 1 < args.ph_hi) {
            if (ph == 0) cooperative_groups::this_grid().sync();
            else { const int tb = tid_now(wave_s); xcd_barrier((unsigned*)(args.ws + WS_CTL) + CW_BAR, xcc, (volatile LAS unsigned*)(lds + MISC_OFF) + 8, tb == 0); }
        }
#endif
    }
}

extern "C" void kernel_launch(void* const* d_in, const int* in_sizes, int n_in, void* d_out, int out_size, void* d_ws, size_t ws_size, hipStream_t stream) {
    static int grid = 0;
    if (grid == 0) {
        if (n_in != 21 || in_sizes[0] != M * DM || out_size != M * DM || ws_size < WS_END) { fprintf(stderr, "kernel_launch: unexpected shapes / workspace (%d inputs, ws %zu)\n", n_in, ws_size); grid = -1; return; }
        int dev = 0, cus = 0;
        if (hipGetDevice(&dev) != hipSuccess || hipDeviceGetAttribute(&cus, hipDeviceAttributeMultiprocessorCount, dev) != hipSuccess) { grid = -1; return; }
        if (hipFuncSetAttribute((const void*)skel_fwd, hipFuncAttributeMaxDynamicSharedMemorySize, LDS_BYTES) != hipSuccess) { fprintf(stderr, "kernel_launch: hipFuncSetAttribute failed\n"); grid = -1; return; }
        (void)hipGetLastError();
        grid = 256;
        if (cus != 256) fprintf(stderr, "kernel_launch: device has %d CUs; this kernel is built for 256\n", cus);
    }
    if (grid < 0) return;
    (void)hipMemsetAsync((char*)d_ws + WS_CTL, 0, CTL_ZERO_BYTES, stream);
    Args a{};
    for (int i = 0; i < 21; ++i) a.in[i] = (const float*)d_in[i];
    a.out = (float*)d_out; a.ws = (unsigned char*)d_ws;
#if MK_ONE_LAUNCH
    a.ph_lo = 0; a.ph_hi = NPHASE;
    void* kargs[] = {&a};
    const hipError_t e = hipLaunchCooperativeKernel((const void*)skel_fwd, dim3(grid), dim3(NWAVES * 64), kargs, LDS_BYTES, stream);
    if (e != hipSuccess) fprintf(stderr, "kernel_launch: cooperative launch failed: %s\n", hipGetErrorString(e));
#else
    for (int ph = 0; ph < NPHASE; ++ph) {
        a.ph_lo = ph; a.ph_hi = ph + 1;
        hipLaunchKernelGGL(skel_fwd, dim3(grid), dim3(NWAVES * 64), LDS_BYTES, stream, a);
    }
#endif
}
```

```cpp
#include <hip/hip_runtime.h>
#include <hip/hip_cooperative_groups.h>
#include <cstdio>
#include <cstdint>

#ifndef MK_ONE_LAUNCH
#define MK_ONE_LAUNCH 1
#endif

#define LAS __attribute__((address_space(3)))
#define GAS __attribute__((address_space(1)))
typedef unsigned short bf16_t;
typedef short bf16x8 __attribute__((ext_vector_type(8)));
typedef float f32x4 __attribute__((ext_vector_type(4)));
typedef float f32x2 __attribute__((ext_vector_type(2)));
typedef unsigned u32x4 __attribute__((ext_vector_type(4)));
typedef unsigned u32x2 __attribute__((ext_vector_type(2)));

constexpr int M = 16384, DM = 1024, FF = 2816, NGU = 2 * FF, NIN = 5120, SEQ = 4096, NBATCH = 4, NHEAD = 8, HD = 64, CW = 512, AW = 512, PLED = 256, DEPTH = 2, NBLK = 16;
constexpr float EPS = 1e-6f;
constexpr float LOG2E = 1.4426950408889634f;
constexpr float C2 = 0.125f * LOG2E;

constexpr size_t MiB = 1u << 20;
constexpr size_t WS_CTL = 0, CTL_ZERO_BYTES = 1 * MiB;
constexpr size_t WO_GU1 = 0, WO_D1 = WO_GU1 + (size_t)NGU * DM, WO_IN = WO_D1 + (size_t)DM * FF, WO_C = WO_IN + (size_t)NIN * DM, WO_A = WO_C + (size_t)DM * CW,
                 WO_O = WO_A + (size_t)DM * AW, WO_GU2 = WO_O + (size_t)DM * DM, WO_D2 = WO_GU2 + (size_t)NGU * DM, WO_PG = WO_D2 + (size_t)DM * FF, WO_PP = WO_PG + (size_t)DM * DM,
                 WL_ELEMS = WO_PP + (size_t)DM * PLED;
static_assert(WL_ELEMS == 25952256, "weight block");
constexpr size_t WS_W = 1 * MiB;
constexpr size_t WS_HB = 100 * MiB;
constexpr size_t WS_X = 132 * MiB;
constexpr size_t X_BG = 0, X_U = 16 * MiB, X_Q = 32 * MiB, X_K = 48 * MiB, X_V = 64 * MiB, X_SGC = 80 * MiB, X_SGA = 112 * MiB;
constexpr size_t X_ACT = 0, X_MERGED = 0, X_T2 = 88 * MiB, X_PB = 120 * MiB;
constexpr size_t WS_SSQ0 = 276 * MiB, WS_SSQ1 = WS_SSQ0 + 256 * 1024, WS_KSUM = WS_SSQ1 + 256 * 1024, WS_COS = 277 * MiB, WS_SIN = 279 * MiB, WS_END = 281 * MiB;
static_assert(WS_W + 2 * WL_ELEMS * 2 <= WS_HB, "weights fit");
static_assert((size_t)M * FF * 2 <= 88 * MiB, "ACT fits");

constexpr int RING_BYTES = 131072;
constexpr int LDSCTL_OFF = RING_BYTES, MISC_OFF = LDSCTL_OFF + 320;
constexpr int LDS_BYTES = 147456;
constexpr int NWAVES = 8;

#define LDS_WAIT() asm volatile("s_waitcnt lgkmcnt(0)" ::: "memory")
#define VM_WAIT() asm volatile("s_waitcnt vmcnt(0)" ::: "memory")
#define RLX_AGENT __ATOMIC_RELAXED, __HIP_MEMORY_SCOPE_AGENT

__device__ __forceinline__ unsigned f2bf(float f) { unsigned u = __builtin_bit_cast(unsigned, f); return (u + 0x7fffu + ((u >> 16) & 1u)) >> 16; }
__device__ __forceinline__ unsigned pk2(float lo, float hi) { return f2bf(lo) | (f2bf(hi) << 16); }
__device__ __forceinline__ unsigned cvt_pk_bf16(float lo, float hi) { unsigned r; asm volatile("v_cvt_pk_bf16_f32 %0, %1, %2" : "=v"(r) : "v"(lo), "v"(hi)); return r; }
__device__ __forceinline__ float bf_lo(unsigned w) { return __builtin_bit_cast(float, w << 16); }
__device__ __forceinline__ float bf_hi(unsigned w) { return __builtin_bit_cast(float, w & 0xffff0000u); }
__device__ __forceinline__ float rstd_of(const float* ssq, int r) { const f32x4 s = *(const f32x4*)(ssq + 4 * (size_t)r); return rsqrtf(((s.x + s.y) + (s.z + s.w)) * (1.0f / DM) + EPS); }
__device__ __forceinline__ int tid_now(int wave_s) { int l; asm volatile("v_mbcnt_lo_u32_b32 %0, -1, 0\n\tv_mbcnt_hi_u32_b32 %0, -1, %0" : "=v"(l)); return wave_s * 64 + l; }
template <class T> __device__ __forceinline__ T ldg(const void* base, unsigned boff) { return *(const T*)((const char*)base + boff); }
template <class T> __device__ __forceinline__ void stg(void* base, unsigned boff, T v) { *(T*)((char*)base + boff) = v; }
__device__ __forceinline__ float rstd_at(const float* ssq, int r) { const f32x4 s = ldg<f32x4>(ssq, (unsigned)r * 16u); return __builtin_amdgcn_rsqf(((s.x + s.y) + (s.z + s.w)) * (1.0f / DM) + EPS); }
__device__ __forceinline__ float shx(float v, int mask, int lane) { return __builtin_bit_cast(float, __builtin_amdgcn_ds_bpermute((lane ^ mask) << 2, __builtin_bit_cast(int, v))); }
__device__ __forceinline__ float sigmoidf_(float x) { return __builtin_amdgcn_rcpf(1.0f + __builtin_amdgcn_exp2f(-x * LOG2E)); }

namespace pg8 {
constexpr int BM = 256, BK = 64, HALF = 128, HTB = HALF * BK * 2, STAGE_BYTES = 8 * HTB, NXCD = 8, WGM = 8;
__host__ __device__ __forceinline__ int lds_byte(int r, int c) { const int st = (r >> 4) * 2 + (c >> 5), rr = r & 15, cc = c & 31, ob = rr * 64 + cc * 2; return st * 1024 + (ob ^ (((ob >> 9) & 1) << 5)); }
__host__ __device__ __forceinline__ void stage_rc(int b, int& R, int& C) { const int st = b / 1024, sb = b % 1024, swz = sb ^ (((sb >> 9) & 1) << 5); R = (st >> 1) * 16 + swz / 64; C = (st & 1) * 32 + (swz % 64) / 2; }
__host__ __device__ __forceinline__ int perm32(int rho) { const int n = rho >> 4, i = rho & 15; return 8 * (i >> 2) + 4 * n + (i & 3); }

struct Unit { int pm, pn, seg; };
struct Gemm { const bf16_t* A0; const bf16_t* B0; const bf16_t* A1; const bf16_t* B1; int K; };

struct StaticOrder {
    int nM, nN, nwg, G, c;
    __device__ void init(int M_, int N_, int G_, int c_) { nM = M_ / BM; nN = N_ / BM; nwg = nM * nN; G = G_; c = c_; }
    __device__ bool next(int i, Unit& u) const {
        const long L = (long)i * G + c; if (L >= nwg) return false;
        int wgid = (int)L; { const int q = nwg / NXCD, r = nwg % NXCD, xcd = wgid % NXCD, off = wgid / NXCD; wgid = (xcd < r ? xcd * (q + 1) : r * (q + 1) + (xcd - r) * q) + off; }
        const int nig = WGM * nN, gid = wgid / nig, fm = gid * WGM, gsz = (nM - fm) < WGM ? (nM - fm) : WGM;
        u.pm = fm + ((wgid % nig) % gsz); u.pn = (wgid % nig) / gsz; u.seg = 0; return true;
    }
};
struct TwoSegOrder {
    StaticOrder so;
    __device__ bool next(int i, Unit& u) const { if (i >= 2) return false; const bool ok = so.next(0, u); u.seg = i; return ok; }
};

template <class Epi, class Sched, bool ALIGN_EPI>
__device__ __forceinline__ void gemm_phase(LAS unsigned char* lds, const Gemm g, const Sched& S, const Epi& E, int wave_s) {
    const int tid = tid_now(wave_s), wid = __builtin_amdgcn_readfirstlane(tid >> 6), lane = tid & 63, wr = wid >> 2, wc = wid & 3, fr = lane & 15, fq = lane >> 4;
    const int K = g.K, nt = K / BK;
    unsigned voffA[2], voffB[2];
#pragma unroll
    for (int i = 0; i < 2; ++i) { int R, C; stage_rc(tid * 16 + i * 8192, R, C); const int Rb = Epi::PERM ? ((R & ~31) + perm32(R & 31)) : R;
        voffA[i] = (unsigned)(R * K + C) * 2u; voffB[i] = (unsigned)(Rb * K + C) * 2u; }
    const size_t kstep = (size_t)(BK * 2);
    const size_t hstep = (size_t)HALF * K * 2;
    const size_t tstep = 2 * hstep;
    const unsigned ldsw = (unsigned)wid * 1024u;
    const int aoff = lds_byte(wr * 64 + fr, fq * 8), boff = lds_byte(wc * 32 + fr, fq * 8);
#define PG8_SA(b, h) (((b) * 2 + (h)) * HTB)
#define PG8_SB(b, h) ((4 + (b) * 2 + (h)) * HTB)
#define PG8_STAGE(bufoff, gbase, voff) do { _Pragma("unroll") for (int _i = 0; _i < 2; ++_i) \
        __builtin_amdgcn_global_load_lds((const unsigned*)((const char*)(gbase) + (voff)[_i]), (LAS unsigned*)(lds + (bufoff) + ldsw + _i * 8192), 16, 0, 0); } while (0)
#define PG8_LDA(dst, b, h) do { _Pragma("unroll") for (int m = 0; m < 4; ++m) _Pragma("unroll") for (int k = 0; k < 2; ++k) dst[m][k] = *(const LAS bf16x8*)(lds + PG8_SA(b, h) + aoff + m * 2048 + k * 1024); } while (0)
#define PG8_LDB(dst, b, h) do { _Pragma("unroll") for (int n = 0; n < 2; ++n) _Pragma("unroll") for (int k = 0; k < 2; ++k) dst[n][k] = *(const LAS bf16x8*)(lds + PG8_SB(b, h) + boff + n * 2048 + k * 1024); } while (0)
#define PG8_MMA(ai, bj, At, Bt) do { __builtin_amdgcn_s_setprio(1); _Pragma("unroll") for (int m = 0; m < 4; ++m) _Pragma("unroll") for (int n = 0; n < 2; ++n) _Pragma("unroll") for (int k = 0; k < 2; ++k) \
        acc[ai][bj][m][n] = __builtin_amdgcn_mfma_f32_16x16x32_bf16(Bt[n][k], At[m][k], acc[ai][bj][m][n], 0, 0, 0); __builtin_amdgcn_s_setprio(0); } while (0)
#define PG8_WAIT_V(n) asm volatile("s_waitcnt vmcnt(" #n ")" ::: "memory")
#define PG8_WAIT_L(n) asm volatile("s_waitcnt lgkmcnt(" #n ")" ::: "memory")
#define PG8_BAR __builtin_amdgcn_s_barrier()
#define PG8_SCHED __builtin_amdgcn_sched_barrier(0)
    Unit cur, nxt; int ui = 0;
    if (!S.next(0, cur)) return;
    f32x4 acc[2][2][4][2];
#pragma unroll
    for (int a = 0; a < 2; ++a)
#pragma unroll
        for (int b = 0; b < 2; ++b)
#pragma unroll
            for (int m = 0; m < 4; ++m)
#pragma unroll
                for (int n = 0; n < 2; ++n) acc[a][b][m][n] = (f32x4){0.f, 0.f, 0.f, 0.f};
    bf16x8 At[4][2], B0[2][2], B1[2][2];
    const char* cA = (const char*)(cur.seg ? g.A1 : g.A0) + (size_t)cur.pm * tstep; const char* cB = (const char*)(cur.seg ? g.B1 : g.B0) + (size_t)cur.pn * tstep;
    PG8_STAGE(PG8_SB(0, 0), cB, voffB); PG8_STAGE(PG8_SB(0, 1), cB + hstep, voffB); PG8_STAGE(PG8_SA(0, 0), cA, voffA); PG8_STAGE(PG8_SA(0, 1), cA + hstep, voffA);
    if (wr == 1) PG8_BAR;
    PG8_WAIT_V(2); PG8_BAR;
    PG8_STAGE(PG8_SB(1, 0), cB + kstep, voffB); PG8_STAGE(PG8_SA(1, 0), cA + kstep, voffA); PG8_STAGE(PG8_SB(1, 1), cB + hstep + kstep, voffB);
    PG8_WAIT_V(6); PG8_BAR;
    for (;;) {
        const bool has_next = S.next(ui + 1, nxt);
        const char* nA = has_next ? (const char*)(nxt.seg ? g.A1 : g.A0) + (size_t)nxt.pm * tstep : cA; const char* nB = has_next ? (const char*)(nxt.seg ? g.B1 : g.B0) + (size_t)nxt.pn * tstep : cB;
        for (int t = 0; t < nt; t += 2) {
            const bool last = (t == nt - 2);
            const char* a1 = cA + (size_t)(t + 1) * kstep;
            const char* a2 = last ? nA : cA + (size_t)(t + 2) * kstep; const char* b2 = last ? nB : cB + (size_t)(t + 2) * kstep;
            const char* a3 = a2 + kstep; const char* b3 = b2 + kstep;
            PG8_LDB(B0, 0, 0); PG8_LDB(B1, 0, 1); PG8_SCHED; PG8_LDA(At, 0, 0); PG8_STAGE(PG8_SA(1, 1), a1 + hstep, voffA);
            PG8_WAIT_V(8); PG8_WAIT_L(0); PG8_BAR; PG8_MMA(0, 0, At, B0); PG8_MMA(0, 1, At, B1); PG8_BAR; PG8_SCHED;
            PG8_LDA(At, 0, 1); PG8_STAGE(PG8_SB(0, 0), b2, voffB); PG8_STAGE(PG8_SB(0, 1), b2 + hstep, voffB); PG8_STAGE(PG8_SA(0, 0), a2, voffA);
            PG8_WAIT_V(8); PG8_WAIT_L(0); PG8_BAR; PG8_MMA(1, 0, At, B0); PG8_MMA(1, 1, At, B1); PG8_BAR; PG8_SCHED;
            PG8_LDB(B0, 1, 0); PG8_LDB(B1, 1, 1); PG8_SCHED; PG8_LDA(At, 1, 0); PG8_STAGE(PG8_SA(0, 1), a2 + hstep, voffA);
            PG8_WAIT_V(8); PG8_WAIT_L(0); PG8_BAR; PG8_MMA(0, 0, At, B0); PG8_MMA(0, 1, At, B1); PG8_BAR; PG8_SCHED;
            PG8_LDA(At, 1, 1); PG8_STAGE(PG8_SB(1, 0), b3, voffB); PG8_STAGE(PG8_SB(1, 1), b3 + hstep, voffB); PG8_STAGE(PG8_SA(1, 0), a3, voffA);
            PG8_WAIT_V(8); PG8_WAIT_L(0); PG8_BAR; PG8_MMA(1, 0, At, B0); PG8_MMA(1, 1, At, B1); PG8_BAR; PG8_SCHED;
        }
        if constexpr (ALIGN_EPI) { if (wr == 0) PG8_BAR; }
        if constexpr (!Epi::AFTER_DRAIN) { const int l2 = tid_now(wave_s) & 63;
            E(acc, cur, wr, wc, l2 & 15, l2 >> 4); }
        if (!has_next) break;
        if (!(Epi::CARRY && nxt.seg != 0)) {
#pragma unroll
        for (int a = 0; a < 2; ++a)
#pragma unroll
            for (int b = 0; b < 2; ++b)
#pragma unroll
                for (int m = 0; m < 4; ++m)
#pragma unroll
                    for (int n = 0; n < 2; ++n) acc[a][b][m][n] = (f32x4){0.f, 0.f, 0.f, 0.f};
        }
        cur = nxt; cA = nA; cB = nB; ++ui;
        if constexpr (ALIGN_EPI) { if (wr == 1) PG8_BAR; }
    }
    PG8_WAIT_V(0);
    if constexpr (!ALIGN_EPI) { if (wr == 0) PG8_BAR; }
    PG8_BAR;
    if constexpr (Epi::AFTER_DRAIN) { const int l2 = tid_now(wave_s) & 63; E.fused(acc, cur, wr, wc, l2 & 15, l2 >> 4, lds, wid, l2); }
#undef PG8_SA
#undef PG8_SB
#undef PG8_STAGE
#undef PG8_LDA
#undef PG8_LDB
#undef PG8_MMA
#undef PG8_WAIT_V
#undef PG8_WAIT_L
#undef PG8_BAR
#undef PG8_SCHED
}

typedef f32x4 (&AccRef)[2][2][4][2];
#define ROWGROUP_BEGIN(r, expr) int r = (expr); asm volatile("" : "+v"(r) :: "memory")
__device__ __forceinline__ u32x4 pack8(const f32x4 a, const f32x4 b) { u32x4 w; w.x = cvt_pk_bf16(a[0], a[1]); w.y = cvt_pk_bf16(a[2], a[3]); w.z = cvt_pk_bf16(b[0], b[1]); w.w = cvt_pk_bf16(b[2], b[3]); return w; }
__device__ __forceinline__ void unpack8(const u32x4 t, f32x4& a, f32x4& b) { a = (f32x4){bf_lo(t.x), bf_hi(t.x), bf_lo(t.y), bf_hi(t.y)}; b = (f32x4){bf_lo(t.z), bf_hi(t.z), bf_lo(t.w), bf_hi(t.w)}; }

struct EpiSwiglu {
    static constexpr bool PERM = true, AFTER_DRAIN = false, CARRY = false;
    bf16_t* ACT; const float* ssq;
    __device__ __forceinline__ void operator()(AccRef acc, const Unit& u, int wr, int wc, int fr, int fq) const {
        const int row0 = u.pm * BM + wr * 64 + fr, col0 = u.pn * 128 + wc * 32 + 8 * fq;
#pragma unroll
        for (int ai = 0; ai < 2; ++ai)
#pragma unroll
            for (int m = 0; m < 4; ++m) { ROWGROUP_BEGIN(r, row0 + ai * HALF + m * 16); const float rs = rstd_at(ssq, r);
                f32x4 o0, o1;
#pragma unroll
                for (int i = 0; i < 4; ++i) { const float g0 = acc[ai][0][m][0][i] * rs, u0 = acc[ai][1][m][0][i] * rs, g1 = acc[ai][0][m][1][i] * rs, u1 = acc[ai][1][m][1][i] * rs;
                    o0[i] = g0 * u0 * sigmoidf_(g0); o1[i] = g1 * u1 * sigmoidf_(g1); }
                stg<u32x4>(ACT, (unsigned)(r * FF + col0) * 2u, pack8(o0, o1)); }
    }
};

struct EpiPlain {
    static constexpr bool PERM = true, AFTER_DRAIN = false, CARRY = false;
    bf16_t* O; int ldc;
    __device__ __forceinline__ void operator()(AccRef acc, const Unit& u, int wr, int wc, int fr, int fq) const {
        const int row0 = u.pm * BM + wr * 64 + fr, col0 = u.pn * BM + wc * 32 + 8 * fq;
#pragma unroll
        for (int ai = 0; ai < 2; ++ai)
#pragma unroll
            for (int m = 0; m < 4; ++m) { ROWGROUP_BEGIN(r, row0 + ai * HALF + m * 16);
#pragma unroll
                for (int bj = 0; bj < 2; ++bj) stg<u32x4>(O, (unsigned)(r * ldc + col0 + bj * HALF) * 2u, pack8(acc[ai][bj][m][0], acc[ai][bj][m][1])); }
    }
};

struct EpiWin {
    static constexpr bool PERM = true, AFTER_DRAIN = false, CARRY = false;
    unsigned char* ws; const float* ssq;
    __device__ __forceinline__ void operator()(AccRef acc, const Unit& u, int wr, int wc, int fr, int fq) const {
        const int pn = u.pn, row0 = u.pm * BM + wr * 64 + fr, cw = wc * 32 + 8 * fq;
        unsigned char* X = ws + WS_X;
        if (pn >= 2 && pn < 6) {
            const int col0 = (pn - 2) * 128 + cw;
#pragma unroll
            for (int ai = 0; ai < 2; ++ai)
#pragma unroll
                for (int m = 0; m < 4; ++m) { ROWGROUP_BEGIN(r, row0 + ai * HALF + m * 16); const float rs = rstd_at(ssq, r), rs2 = rs * rs;
                    stg<u32x4>(X + X_U, (unsigned)(r * CW + col0) * 2u, pack8(acc[ai][0][m][0] * acc[ai][1][m][0] * rs2, acc[ai][0][m][1] * acc[ai][1][m][1] * rs2)); }
        } else if (pn >= 6 && pn < 10) {
            const bool isk = pn >= 8; const int head = ((pn - 6) & 1) * 4 + wc, dd0 = 8 * fq; unsigned char* dst = X + (isk ? X_K : X_Q); const float osc = isk ? 1.0f : C2;
            f32x4 cs[2][2];
#pragma unroll
            for (int a = 0; a < 2; ++a)
#pragma unroll
                for (int b = 0; b < 2; ++b) cs[a][b] = (f32x4){0.f, 0.f, 0.f, 0.f};
#pragma unroll
            for (int ai = 0; ai < 2; ++ai)
#pragma unroll
                for (int m = 0; m < 4; ++m) { ROWGROUP_BEGIN(r, row0 + ai * HALF + m * 16); const float rs = rstd_at(ssq, r);
                    f32x4 y1[2], y2[2];
#pragma unroll
                    for (int n = 0; n < 2; ++n) { const f32x4 c4 = ldg<f32x4>(ws + WS_COS, (unsigned)(r * 32 + dd0 + 4 * n) * 4u), s4 = ldg<f32x4>(ws + WS_SIN, (unsigned)(r * 32 + dd0 + 4 * n) * 4u);
                        const f32x4 x1 = acc[ai][0][m][n] * rs, x2 = acc[ai][1][m][n] * rs;
                        y1[n] = x1 * c4 - x2 * s4; y2[n] = x2 * c4 + x1 * s4; cs[0][n] += y1[n]; cs[1][n] += y2[n]; }
                    stg<u32x4>(dst, (unsigned)(r * AW + head * 64 + dd0) * 2u, pack8(y1[0] * osc, y1[1] * osc));
                    stg<u32x4>(dst, (unsigned)(r * AW + head * 64 + 32 + dd0) * 2u, pack8(y2[0] * osc, y2[1] * osc));
                    asm volatile("" : "+v"(cs[0][0]), "+v"(cs[0][1]), "+v"(cs[1][0]), "+v"(cs[1][1])); }
            if (isk) {
#pragma unroll
                for (int b = 0; b < 2; ++b)
#pragma unroll
                    for (int n = 0; n < 2; ++n)
#pragma unroll
                        for (int i = 0; i < 4; ++i) { const int ln = fq * 16 + fr; float v = cs[b][n][i]; v += shx(v, 1, ln); v += shx(v, 2, ln); v += shx(v, 4, ln); v += shx(v, 8, ln); cs[b][n][i] = v; }
                if (fr == 0) {
#pragma unroll
                    for (int b = 0; b < 2; ++b)
#pragma unroll
                        for (int n = 0; n < 2; ++n) stg<f32x4>(ws + WS_KSUM, (unsigned)((u.pm * 2 + wr) * 512 + head * 64 + dd0 + 32 * b + 4 * n) * 4u, cs[b][n]); }
            }
        } else {
            const bool gate = pn >= 12; unsigned char* dst; int ldc, colt;
            if (pn < 2) { dst = X + X_BG; ldc = CW; colt = pn * 256; } else if (pn < 12) { dst = X + X_V; ldc = AW; colt = (pn - 10) * 256; }
            else if (pn < 16) { dst = X + X_SGC; ldc = DM; colt = (pn - 12) * 256; } else { dst = X + X_SGA; ldc = DM; colt = (pn - 16) * 256; }
#pragma unroll
            for (int ai = 0; ai < 2; ++ai)
#pragma unroll
                for (int m = 0; m < 4; ++m) { ROWGROUP_BEGIN(r, row0 + ai * HALF + m * 16); const float rs = rstd_at(ssq, r);
#pragma unroll
                    for (int bj = 0; bj < 2; ++bj) { f32x4 v0 = acc[ai][bj][m][0] * rs, v1 = acc[ai][bj][m][1] * rs;
                        if (gate) {
#pragma unroll
                            for (int i = 0; i < 4; ++i) { v0[i] = sigmoidf_(v0[i]); v1[i] = sigmoidf_(v1[i]); } }
                        stg<u32x4>(dst, (unsigned)(r * ldc + colt + bj * HALF + cw) * 2u, pack8(v0, v1)); } }
        }
    }
};

struct EpiMerge {
    static constexpr bool PERM = true, AFTER_DRAIN = false, CARRY = true;
    const bf16_t *SGC, *SGA; bf16_t* MG;
    __device__ __forceinline__ void operator()(AccRef acc, const Unit& u, int wr, int wc, int fr, int fq) const {
        const int row0 = u.pm * BM + wr * 64 + fr, col0 = u.pn * BM + wc * 32 + 8 * fq;
#pragma unroll
        for (int ai = 0; ai < 2; ++ai)
#pragma unroll
            for (int m = 0; m < 4; ++m) { ROWGROUP_BEGIN(r, row0 + ai * HALF + m * 16);
#pragma unroll
                for (int bj = 0; bj < 2; ++bj) { const unsigned off = (unsigned)(r * DM + col0 + bj * HALF) * 2u;
                    f32x4 sa0, sa1; unpack8(ldg<u32x4>(SGA, off), sa0, sa1);
#pragma unroll
                    for (int i = 0; i < 4; ++i) { sa0[i] = fmaxf(sa0[i], 1e-30f); sa1[i] = fmaxf(sa1[i], 1e-30f); }
                    if (u.seg == 0) { f32x4 sc0, sc1; unpack8(ldg<u32x4>(SGC, off), sc0, sc1);
#pragma unroll
                        for (int i = 0; i < 4; ++i) { acc[ai][bj][m][0][i] *= sc0[i] / sa0[i]; acc[ai][bj][m][1][i] *= sc1[i] / sa1[i]; }
                    } else stg<u32x4>(MG, off, pack8(acc[ai][bj][m][0] * sa0, acc[ai][bj][m][1] * sa1)); } }
    }
};

template <int MODE> struct EpiRes {
    static constexpr bool PERM = true, AFTER_DRAIN = true, CARRY = false;
    const float* hin; float* hout; bf16_t* HB; float* ssq_out; float scale; const float* ssq_in; const bf16_t* T2;
    __device__ __forceinline__ void fused(AccRef acc, const Unit& u, int wr, int wc, int fr, int fq, LAS unsigned char* lds, int wid, int lane) const {
        LAS float* P = (LAS float*)lds;
        const int row0 = u.pm * BM + wr * 64 + fr, col0 = u.pn * BM + wc * 32 + 8 * fq;
#pragma unroll
        for (int ai = 0; ai < 2; ++ai)
#pragma unroll
            for (int m = 0; m < 4; ++m) { ROWGROUP_BEGIN(r, row0 + ai * HALF + m * 16); float q = 0.f;
                float rs = 1.f; if (MODE == 1) rs = rstd_at(ssq_in, r);
#pragma unroll
                for (int bj = 0; bj < 2; ++bj) { const unsigned e = (unsigned)(r * DM + col0 + bj * HALF);
                    const f32x4 h0 = ldg<f32x4>(hin, e * 4u), h1 = ldg<f32x4>(hin, e * 4u + 16u);
                    f32x4 y0, y1;
                    if (MODE == 0) { y0 = h0 + acc[ai][bj][m][0] * scale; y1 = h1 + acc[ai][bj][m][1] * scale; }
                    else { f32x4 t0, t1; unpack8(ldg<u32x4>(T2, e * 2u), t0, t1);
#pragma unroll
                        for (int i = 0; i < 4; ++i) { y0[i] = h0[i] + scale * sigmoidf_(acc[ai][bj][m][0][i] * rs) * t0[i]; y1[i] = h1[i] + scale * sigmoidf_(acc[ai][bj][m][1][i] * rs) * t1[i]; } }
                    stg<f32x4>(hout, e * 4u, y0); stg<f32x4>(hout, e * 4u + 16u, y1);
                    stg<u32x4>(HB, e * 2u, pack8(y0, y1));
                    q += (y0[0] * y0[0] + y0[1] * y0[1]) + (y0[2] * y0[2] + y0[3] * y0[3]) + (y1[0] * y1[0] + y1[1] * y1[1]) + (y1[2] * y1[2] + y1[3] * y1[3]); }
                q += shx(q, 16, lane); q += shx(q, 32, lane);
                if (fq == 0) P[(ai * HALF + wr * 64 + m * 16 + fr) * 4 + wc] = q; }
        asm volatile("s_waitcnt lgkmcnt(0)" ::: "memory"); __builtin_amdgcn_s_barrier(); asm volatile("" ::: "memory");
        const int t = wid * 64 + lane;
        if (t < 256) { const f32x4 p = *(const LAS f32x4*)(P + 4 * t); ssq_out[(size_t)(u.pm * BM + t) * 4 + u.pn] = (p.x + p.y) + (p.z + p.w); }
        asm volatile("s_waitcnt lgkmcnt(0)" ::: "memory"); __builtin_amdgcn_s_barrier(); asm volatile("" ::: "memory");
    }
};
}

#include <hip/hip_bf16.h>
#include <cmath>
namespace moba {
using bf16=__hip_bfloat16;
using bf16x8=__attribute__((ext_vector_type(8)))short;
using s16x4=__attribute__((ext_vector_type(4)))short;
using f32x16=__attribute__((ext_vector_type(16)))float;
using u32x4=__attribute__((ext_vector_type(4)))unsigned;
constexpr int BATCH=4,NHEAD=8,SEQ=4096,D=64,DM=NHEAD*D;
constexpr int NW=8,QBLK=32,QB=QBLK*NW,KVBLK=64,NQB=SEQ/QB;
constexpr int ATTN_PITCH=DM, ATTN_UNIT_ROWS=QB;
__device__ __forceinline__ int crow(int r,int hi){return (r&3)+8*(r>>2)+4*hi;}
#define SBAR() __builtin_amdgcn_sched_barrier(0)
__device__ __forceinline__ void cmask(f32x16&p0,f32x16&p1,int jb,int qrel,int hi){
  const float NEG=-INFINITY; int kb=64*jb+4*hi;
  #pragma unroll
  for(int r=0;r<16;++r){int kv=kb+(r&3)+8*(r>>2); if(kv>qrel)p0[r]=NEG; if(kv+32>qrel)p1[r]=NEG;}
}

constexpr int NSLOT=3, SLOTB=8192;
constexpr int LDS_K=0, LDS_V=NSLOT*SLOTB, LDS_WS=2*NSLOT*SLOTB, LDS_OST=LDS_WS+NW*64*4, LDS_KS=LDS_OST+NW*4096, LDS_BYTES=LDS_KS+4096;
constexpr float C2=0.125f*1.4426950408889634f;
__device__ __forceinline__ void glds16(const void*gsrc,unsigned lds_dst){unsigned keep;
  asm volatile("s_mov_b32 %0, m0\n\ts_mov_b32 m0, %2\n\ts_nop 0\n\tglobal_load_lds_dwordx4 %1, off\n\ts_mov_b32 m0, %0":"=&s"(keep):"v"(gsrc),"s"(lds_dst):"memory");}
__device__ __forceinline__ float max3f(float a,float b,float c){float r;asm("v_max3_f32 %0, %1, %2, %3":"=v"(r):"v"(a),"v"(b),"v"(c));return r;}
__device__ __forceinline__ float max2f(float a,float b){float r;asm("v_max_f32_e32 %0, %1, %2":"=v"(r):"v"(a),"v"(b));return r;}
__device__ __forceinline__ float fadd_s(float a,float b){float r;asm("v_add_f32_e32 %0, %1, %2":"=v"(r):"v"(a),"v"(b));return r;}
__device__ __forceinline__ float fsub_s(float a,float b){float r;asm("v_sub_f32_e32 %0, %1, %2":"=v"(r):"v"(a),"v"(b));return r;}
typedef float f32x2_t __attribute__((ext_vector_type(2))); typedef __bf16 bf16x2_t __attribute__((ext_vector_type(2)));
__device__ __forceinline__ unsigned cvtpk_s(float lo,float hi){f32x2_t v={lo,hi};bf16x2_t b=__builtin_convertvector(v,bf16x2_t);return __builtin_bit_cast(unsigned,b);}
#define WAIT_BAR(N) asm volatile("s_waitcnt vmcnt(" #N ") lgkmcnt(0)\n\ts_barrier":::"memory")

__device__ __forceinline__ void qkt(f32x16&p0,f32x16&p1,const char*Kslot,const bf16x8*qr,int r32,int hi){
  const char*kb=Kslot+hi*1024+r32*16;
  #pragma unroll
  for(int d0=0;d0<4;++d0){
    const bf16x8 b0=*reinterpret_cast<const bf16x8*>(kb+d0*2048);
    const bf16x8 b1=*reinterpret_cast<const bf16x8*>(kb+d0*2048+512);
    if(d0==0){p0=__builtin_amdgcn_mfma_f32_32x32x16_bf16(b0,qr[0],f32x16{},0,0,0);p1=__builtin_amdgcn_mfma_f32_32x32x16_bf16(b1,qr[0],f32x16{},0,0,0);}
    else{p0=__builtin_amdgcn_mfma_f32_32x32x16_bf16(b0,qr[d0],p0,0,0,0);p1=__builtin_amdgcn_mfma_f32_32x32x16_bf16(b1,qr[d0],p1,0,0,0);}}
}
typedef __attribute__((address_space(3))) const char* lds_cptr;
typedef short v4i16_t __attribute__((ext_vector_type(4)));
__device__ __forceinline__ void kload8(bf16x8*kf,lds_cptr kp){
  kf[0]=*(const __attribute__((address_space(3))) bf16x8*)(kp);      kf[1]=*(const __attribute__((address_space(3))) bf16x8*)(kp+512);
  kf[2]=*(const __attribute__((address_space(3))) bf16x8*)(kp+2048); kf[3]=*(const __attribute__((address_space(3))) bf16x8*)(kp+2560);
  kf[4]=*(const __attribute__((address_space(3))) bf16x8*)(kp+4096); kf[5]=*(const __attribute__((address_space(3))) bf16x8*)(kp+4608);
  kf[6]=*(const __attribute__((address_space(3))) bf16x8*)(kp+6144); kf[7]=*(const __attribute__((address_space(3))) bf16x8*)(kp+6656);
}
__device__ __forceinline__ void kload2(bf16x8*kf,lds_cptr kp,int j){ kf[2*j]=*(const __attribute__((address_space(3))) bf16x8*)(kp+j*2048); kf[2*j+1]=*(const __attribute__((address_space(3))) bf16x8*)(kp+j*2048+512); }
__device__ __forceinline__ s16x4 vtr(lds_cptr p){ return __builtin_bit_cast(s16x4,__builtin_amdgcn_ds_read_tr16_b64_v4i16((__attribute__((address_space(3))) v4i16_t*)p)); }
__device__ __forceinline__ float rowmax(const f32x16&p0,const f32x16&p1){
  float a=max3f(p0[0],p0[1],p1[0]),b=max3f(p0[2],p0[3],p1[1]);a=max3f(a,p1[2],p1[3]);
  #pragma unroll
  for(int r=4;r<16;r+=4){a=max3f(a,p0[r],p0[r+1]);b=max3f(b,p0[r+2],p0[r+3]);a=max3f(a,p1[r],p1[r+1]);b=max3f(b,p1[r+2],p1[r+3]);}
  const float m=max2f(a,b);
  auto rr=__builtin_amdgcn_permlane32_swap(__float_as_uint(m),__float_as_uint(m),false,false);
  return max2f(__uint_as_float(rr[0]),__uint_as_float(rr[1]));
}
__device__ __forceinline__ void pv(f32x16*o,int vb,bf16x8 pa0,bf16x8 pa1,bf16x8 pa2,bf16x8 pa3){
  #pragma unroll
  for(int d0=0;d0<2;++d0){s16x4 lo[4],hi[4];
    #pragma unroll
    for(int ks=0;ks<4;++ks){
      asm volatile("ds_read_b64_tr_b16 %0,%1 offset:%c2":"=&v"(lo[ks]):"v"(vb),"i"(d0*4096+ks*1024):"memory");
      asm volatile("ds_read_b64_tr_b16 %0,%1 offset:%c2":"=&v"(hi[ks]):"v"(vb),"i"(d0*4096+ks*1024+512):"memory");}
    asm volatile("s_waitcnt lgkmcnt(0)":::"memory");SBAR();
    #define PK(k) (bf16x8){lo[k][0],lo[k][1],lo[k][2],lo[k][3],hi[k][0],hi[k][1],hi[k][2],hi[k][3]}
    o[d0]=__builtin_amdgcn_mfma_f32_32x32x16_bf16(pa0,PK(0),o[d0],0,0,0);
    o[d0]=__builtin_amdgcn_mfma_f32_32x32x16_bf16(pa1,PK(1),o[d0],0,0,0);
    o[d0]=__builtin_amdgcn_mfma_f32_32x32x16_bf16(pa2,PK(2),o[d0],0,0,0);
    o[d0]=__builtin_amdgcn_mfma_f32_32x32x16_bf16(pa3,PK(3),o[d0],0,0,0);
    #undef PK
  }
}

__device__ __forceinline__ void selmask(f32x16&p0,f32x16&p1,bool keep,float mhat){
  const float a=keep?-mhat:-INFINITY;
  #pragma unroll
  for(int r=0;r<16;++r){p0[r]+=a;p1[r]+=a;}
}
#ifndef ATTN_STORE16
#define ATTN_STORE16(p,v) (*(u32x4*)(p)=(v))
#endif
template<int THRL> __device__ __forceinline__ void attn_unit(int b,int h,int qb,const bf16*Q,const bf16*__restrict__ K,const bf16*__restrict__ V,bf16*O,const float*KSUM,char*shm,int wave_s){
  const int tid=tid_now(wave_s),lane=tid&63,r32=lane&31,hi=lane>>5; const int wid=wave_s;
  const long rowbase=(long)b*SEQ; const int q0=qb*QB;
  const bf16*Qw=Q+(rowbase+q0+wid*QBLK)*DM+h*D;
  const bf16*Kh=K+rowbase*DM+h*D,*Vh=V+rowbase*DM+h*D;
  const unsigned lds0=(unsigned)(uintptr_t)shm;
  float*wsf=(float*)(shm+LDS_WS)+wid*64;
  const bf16*ksrc=Kh+(long)lane*DM+wid*8;
  const bf16*vsrc=Vh+(long)(16*(wid&3)+(lane>>2))*DM+(wid>>2)*32+(lane&3)*8;
  const unsigned kdst=lds0+LDS_K+wid*1024, vdst=lds0+LDS_V+wid*1024;
  #define KT(t) (((t)<4)?(4*qb+(t)):((t)-4))
  #define DMA_K(t,slot) glds16(ksrc+(long)KT(t)*KVBLK*DM,(unsigned)__builtin_amdgcn_readfirstlane(kdst+(slot)))
  #define DMA_V(t,slot) glds16(vsrc+(long)KT(t)*KVBLK*DM,(unsigned)__builtin_amdgcn_readfirstlane(vdst+(slot)))
  const int vb0=(int)(lds0+LDS_V)+((lane>>4)&1)*32+(lane&3)*8+(4*hi+((lane&15)>>2))*64;
  const char*Kbase=shm+LDS_K; bf16x8 kf[8];
  const lds_cptr shm3=(lds_cptr)shm; const lds_cptr kp0=shm3+LDS_K+hi*1024+r32*16; const lds_cptr vp0=shm3+LDS_V+((lane>>4)&1)*32+(lane&3)*8+(4*hi+((lane&15)>>2))*64;
  const int NT=4*qb+4;
  DMA_K(0,0);DMA_V(0,0);DMA_K(1,SLOTB);
  bf16x8 qr[4];
  #pragma unroll
  for(int d0=0;d0<4;++d0)qr[d0]=*reinterpret_cast<const bf16x8*>(&Qw[(long)r32*DM+d0*16+hi*8]);
  { float*ksl=(float*)(shm+LDS_KS); const int n_=tid>>5,d2=(tid&31)*2; const float*kp=KSUM+((size_t)(b*16+n_)*2)*512+h*64+d2;
    typedef float f32x2_ __attribute__((ext_vector_type(2)));
    const f32x2_ a_=*(const f32x2_*)kp,c_=*(const f32x2_*)(kp+512); *(f32x2_*)(ksl+n_*64+d2)=a_+c_; }
  DMA_K(2,2*SLOTB);
  asm volatile("s_waitcnt lgkmcnt(0)\n\ts_barrier":::"memory");
  unsigned sel;
  { const lds_cptr ksp=shm3+LDS_KS+hi*32; float qf[32];
    #pragma unroll
    for(int d0=0;d0<4;++d0)
      #pragma unroll
      for(int j=0;j<8;++j)qf[8*d0+j]=__uint_as_float(((unsigned)(unsigned short)qr[d0][j])<<16);
    float v1=-INFINITY,v2=-INFINITY,v3=-INFINITY; int i1=31,i2=31,i3=31;
    #pragma unroll
    for(int n=0;n<16;++n){ float s=0.f;
      #pragma unroll
      for(int d0=0;d0<4;++d0){ typedef float f32x4_ __attribute__((ext_vector_type(4)));
        const f32x4_ k0=*(const __attribute__((address_space(3))) f32x4_*)(ksp+n*256+d0*64), k1=*(const __attribute__((address_space(3))) f32x4_*)(ksp+n*256+d0*64+16);
        s+=qf[8*d0]*k0.x+qf[8*d0+1]*k0.y+qf[8*d0+2]*k0.z+qf[8*d0+3]*k0.w+qf[8*d0+4]*k1.x+qf[8*d0+5]*k1.y+qf[8*d0+6]*k1.z+qf[8*d0+7]*k1.w; }
      { auto rr=__builtin_amdgcn_permlane32_swap(__float_as_uint(s),__float_as_uint(s),false,false); s=__uint_as_float(rr[0])+__uint_as_float(rr[1]); }
      s=(n<qb)?s:-INFINITY;
      if(s>v1){v3=v2;i3=i2;v2=v1;i2=i1;v1=s;i1=n;} else if(s>v2){v3=v2;i3=i2;v2=s;i2=n;} else if(s>v3){v3=s;i3=n;} }
    sel=(1u<<i1)|(1u<<i2)|(1u<<i3); }
  float mhat=0.f,l_reg=0.f;f32x16 o[2];o[0]=f32x16{};o[1]=f32x16{};
  const int qrel=wid*QBLK+r32;
  #define CMASK(P0,P1,t) do{ if((t)<4){cmask(P0,P1,(t),qrel,hi);selmask(P0,P1,true,mhat);} else selmask(P0,P1,((sel>>(((t)-4)>>2))&1u)!=0u,mhat); }while(0)
  bool resc=false;
  #define START(P0,P1) do{ const float rm=rowmax(P0,P1); resc=false; \
    { const float dl=rm; mhat=fadd_s(mhat,dl); \
      _Pragma("unroll") for(int r=0;r<16;++r){P0[r]=fsub_s(P0[r],dl);P1[r]=fsub_s(P1[r],dl);} \
      } \
    _Pragma("unroll") for(int r=0;r<16;++r)P0[r]=__builtin_amdgcn_exp2f(P0[r]); }while(0)
  #define RESC() do{ if(resc){ asm volatile("s_waitcnt lgkmcnt(0)":::"memory"); \
      _Pragma("unroll") for(int d_=0;d_<2;++d_) _Pragma("unroll") for(int r=0;r<16;++r)o[d_][r]*=wsf[crow(r,hi)]; } }while(0)
  f32x16 pA0,pA1,pB0,pB1;
  int sl_prev=0,sl_cur=0,sl_next=SLOTB;
  #define ROT() do{sl_prev=sl_cur;sl_cur=sl_next;sl_next=(sl_next==(NSLOT-1)*SLOTB)?0:sl_next+SLOTB;}while(0)
  WAIT_BAR(3);
  qkt(pA0,pA1,Kbase,qr,r32,hi);asm volatile("s_nop 15\n\ts_nop 7":"+v"(pA0),"+v"(pA1));cmask(pA0,pA1,0,qrel,hi);
  START(pA0,pA1);
  _Pragma("unroll") for(int r=0;r<16;++r)pA1[r]=__builtin_amdgcn_exp2f(pA1[r]);
  WAIT_BAR(0);
  DMA_K(3,0);DMA_V(1,SLOTB);
  ROT();
  kload8(kf,kp0+sl_cur);
  WAIT_BAR(2);
  s16x4 vlo[8],vhi[8]; u32x4 pw0,pw1,pw2,pw3;
  #define PKW(P,B) cvtpk_s(P[B],P[B+1])
  #define PAF(k) __builtin_bit_cast(bf16x8,pw##k)
  #define VFR(i) (bf16x8){vlo[i][0],vlo[i][1],vlo[i][2],vlo[i][3],vhi[i][0],vhi[i][1],vhi[i][2],vhi[i][3]}
  #define PIN(x) asm volatile("":"+v"(x))
  #define MX3(a,b,c) __builtin_fmaxf(__builtin_fmaxf((a),(b)),(c))
  #define GAPA(MF,A0,A1,A2,A3,W0,W1,PW) do{ MF; sacc+=A0; sacc+=A1; sacc+=A2; sacc+=A3; PIN(sacc); W0; W1; PIN(PW); SBAR(); }while(0)
  #define EX(v) __builtin_amdgcn_exp2f(v)
  #define GAPB(MF,X,B) do{ MF; X[B]=EX(X[B]); X[B+1]=EX(X[B+1]); X[B+2]=EX(X[B+2]); X[B+3]=EX(X[B+3]); PIN(X); SBAR(); }while(0)
  #define VRD(i) do{ vlo[i]=vtr(vp_+(((i)>>2)*4096+((i)&3)*1024)); vhi[i]=vtr(vp_+(((i)>>2)*4096+((i)&3)*1024+512)); }while(0)
  #define KRD(G,j) do{ if(G){ kload2(kf,kp0+sl_next,j); SBAR(); } }while(0)
  #define STEP(C0,C1,P0,P1,t,GK,GV,GL) do{ SBAR(); \
    const lds_cptr vp_=vp0+sl_prev; \
    VRD(0); SBAR(); float sacc=(P0[0]+P0[1]); \
    GAPA(C0=__builtin_amdgcn_mfma_f32_32x32x16_bf16(kf[0],qr[0],f32x16{},0,0,0), P0[2],P0[3],P0[4],P0[5],     pw0[0]=PKW(P0,0), pw0[1]=PKW(P0,2), pw0); \
    VRD(4); SBAR(); GAPA(C1=__builtin_amdgcn_mfma_f32_32x32x16_bf16(kf[1],qr[0],f32x16{},0,0,0), P0[6],P0[7],P0[8],P0[9],     pw0[2]=PKW(P0,4), pw0[3]=PKW(P0,6), pw0); \
    VRD(1); SBAR(); GAPA(C0=__builtin_amdgcn_mfma_f32_32x32x16_bf16(kf[2],qr[1],C0,0,0,0),   P0[10],P0[11],P0[12],P0[13], pw1[0]=PKW(P0,8), pw1[1]=PKW(P0,10), pw1); \
    VRD(5); SBAR(); GAPA(C1=__builtin_amdgcn_mfma_f32_32x32x16_bf16(kf[3],qr[1],C1,0,0,0),   P0[14],P0[15],P1[0],P1[1],   pw1[2]=PKW(P0,12),pw1[3]=PKW(P0,14), pw1); \
    VRD(2); SBAR(); GAPA(C0=__builtin_amdgcn_mfma_f32_32x32x16_bf16(kf[4],qr[2],C0,0,0,0),   P1[2],P1[3],P1[4],P1[5],     pw2[0]=PKW(P1,0), pw2[1]=PKW(P1,2), pw2); \
    VRD(6); SBAR(); GAPA(C1=__builtin_amdgcn_mfma_f32_32x32x16_bf16(kf[5],qr[2],C1,0,0,0),   P1[6],P1[7],P1[8],P1[9],     pw2[2]=PKW(P1,4), pw2[3]=PKW(P1,6), pw2); \
    VRD(3); SBAR(); GAPA(C0=__builtin_amdgcn_mfma_f32_32x32x16_bf16(kf[6],qr[3],C0,0,0,0),   P1[10],P1[11],P1[12],P1[13], pw3[0]=PKW(P1,8), pw3[1]=PKW(P1,10), pw3); \
    VRD(7); SBAR(); GAPA(C1=__builtin_amdgcn_mfma_f32_32x32x16_bf16(kf[7],qr[3],C1,0,0,0),   P1[14],P1[15],0.f,0.f,       pw3[2]=PKW(P1,12),pw3[3]=PKW(P1,14), pw3); \
    l_reg+=sacc; \
    if(GK){DMA_K((t)+3,sl_cur);} if(GV){DMA_V((t)+1,sl_next);} \
    CMASK(C0,C1,t); \
    { float a=MX3(C0[0],C0[1],C1[0]),b=MX3(C0[2],C0[3],C1[1]); a=MX3(a,C1[2],C1[3]); \
      _Pragma("unroll") for(int r=4;r<16;r+=4){a=MX3(a,C0[r],C0[r+1]);b=MX3(b,C0[r+2],C0[r+3]);a=MX3(a,C1[r],C1[r+1]);b=MX3(b,C1[r+2],C1[r+3]);} \
      float rm=__builtin_fmaxf(a,b); { auto rr=__builtin_amdgcn_permlane32_swap(__float_as_uint(rm),__float_as_uint(rm),false,false); rm=__builtin_fmaxf(__uint_as_float(rr[0]),__uint_as_float(rr[1])); } \
      resc=false; \
      if(__builtin_expect(__any(rm>(float)THRL),0)){ const float dl=__builtin_fmaxf(rm,0.f); mhat+=dl; \
        _Pragma("unroll") for(int r=0;r<16;++r){C0[r]-=dl;C1[r]-=dl;} \
        const float f=__builtin_amdgcn_exp2f(-dl); l_reg*=f; if(hi==0)wsf[r32]=f; resc=true; } } \
    SBAR(); \
    GAPB(o[0]=__builtin_amdgcn_mfma_f32_32x32x16_bf16(PAF(0),VFR(0),o[0],0,0,0), C0,0); \
    GAPB(o[1]=__builtin_amdgcn_mfma_f32_32x32x16_bf16(PAF(0),VFR(4),o[1],0,0,0), C0,4); \
    KRD(GL,0); GAPB(o[0]=__builtin_amdgcn_mfma_f32_32x32x16_bf16(PAF(1),VFR(1),o[0],0,0,0), C0,8); \
    KRD(GL,1); GAPB(o[1]=__builtin_amdgcn_mfma_f32_32x32x16_bf16(PAF(1),VFR(5),o[1],0,0,0), C0,12); \
    KRD(GL,2); GAPB(o[0]=__builtin_amdgcn_mfma_f32_32x32x16_bf16(PAF(2),VFR(2),o[0],0,0,0), C1,0); \
    KRD(GL,3); GAPB(o[1]=__builtin_amdgcn_mfma_f32_32x32x16_bf16(PAF(2),VFR(6),o[1],0,0,0), C1,4); \
    GAPB(o[0]=__builtin_amdgcn_mfma_f32_32x32x16_bf16(PAF(3),VFR(3),o[0],0,0,0), C1,8); \
    GAPB(o[1]=__builtin_amdgcn_mfma_f32_32x32x16_bf16(PAF(3),VFR(7),o[1],0,0,0), C1,12); \
    }while(0)
  int t=1;
  #define ENDW(tt) do{ if((tt)+3<NT){WAIT_BAR(2);} else if((tt)+2<NT){WAIT_BAR(1);} else {WAIT_BAR(0);} }while(0)
  for(;t<5&&t+1<NT;t+=2){
    STEP(pB0,pB1,pA0,pA1,t,(t+3<NT),(t+1<NT),(t+1<NT));       ENDW(t);   RESC(); ROT();
    STEP(pA0,pA1,pB0,pB1,t+1,(t+4<NT),(t+2<NT),(t+2<NT));     ENDW(t+1); RESC(); ROT();
  }
  #undef CMASK
  #define CMASK(P0,P1,t) selmask(P0,P1,((sel>>(((t)-4)>>2))&1u)!=0u,mhat)
  for(;t+5<NT;t+=2){
    STEP(pB0,pB1,pA0,pA1,t,true,true,true);     WAIT_BAR(2); RESC(); ROT();
    STEP(pA0,pA1,pB0,pB1,t+1,true,true,true);   WAIT_BAR(2); RESC(); ROT();
  }
  for(;t+1<NT;t+=2){
    STEP(pB0,pB1,pA0,pA1,t,(t+3<NT),(t+1<NT),(t+1<NT));       ENDW(t);   RESC(); ROT();
    STEP(pA0,pA1,pB0,pB1,t+1,(t+4<NT),(t+2<NT),(t+2<NT));     ENDW(t+1); RESC(); ROT();
  }
  #undef CMASK
  #define CMASK(P0,P1,t) do{ if((t)<4){cmask(P0,P1,(t),qrel,hi);selmask(P0,P1,true,mhat);} else selmask(P0,P1,((sel>>(((t)-4)>>2))&1u)!=0u,mhat); }while(0)
  STEP(pB0,pB1,pA0,pA1,NT-1,false,false,false); RESC();
  { float sacc=pB0[0]+pB0[1]; _Pragma("unroll") for(int r=2;r<16;++r)sacc+=pB0[r]; _Pragma("unroll") for(int r=0;r<16;++r)sacc+=pB1[r]; l_reg+=sacc;
    pw0=(u32x4){PKW(pB0,0),PKW(pB0,2),PKW(pB0,4),PKW(pB0,6)};pw1=(u32x4){PKW(pB0,8),PKW(pB0,10),PKW(pB0,12),PKW(pB0,14)};pw2=(u32x4){PKW(pB1,0),PKW(pB1,2),PKW(pB1,4),PKW(pB1,6)};pw3=(u32x4){PKW(pB1,8),PKW(pB1,10),PKW(pB1,12),PKW(pB1,14)};
    SBAR(); pv(o,vb0+sl_cur,PAF(0),PAF(1),PAF(2),PAF(3)); }
  #undef PKW
  #undef PAF
  #undef VFR
  #undef PIN
  #undef MX3
  #undef GAPA
  #undef GAPB
  #undef EX
  #undef VRD
  #undef KRD
  #undef STEP
  #undef ENDW
  {auto rr=__builtin_amdgcn_permlane32_swap(__float_as_uint(l_reg),__float_as_uint(l_reg),false,false);l_reg=__uint_as_float(rr[0])+__uint_as_float(rr[1]);}
  if(hi==0)wsf[32+r32]=l_reg;asm volatile("s_waitcnt lgkmcnt(0)":::"memory");
  float rli[16];
  #pragma unroll
  for(int r=0;r<16;++r)rli[r]=__builtin_amdgcn_rcpf(wsf[32+crow(r,hi)]);
  bf16*Ow=O+(rowbase+q0+wid*QBLK)*DM+h*D;
  { bf16*stg=(bf16*)(shm+LDS_OST)+wid*2048;
    #pragma unroll
    for(int r=0;r<16;++r){const int orow=crow(r,hi);
      #pragma unroll
      for(int d0=0;d0<2;++d0)stg[orow*64+d0*32+r32]=__float2bfloat16(o[d0][r]*rli[r]);}
    asm volatile("s_waitcnt lgkmcnt(0)":::"memory");
    #pragma unroll
    for(int i=0;i<4;++i){const int row=i*8+(lane>>3),ch=lane&7; const u32x4 v=*(const u32x4*)(stg+row*64+ch*8); ATTN_STORE16(Ow+(long)row*DM+ch*8,v);} }
  asm volatile("s_waitcnt lgkmcnt(0)\n\ts_barrier":::"memory");
  #undef DMA_K
  #undef DMA_V
  #undef KT
  #undef CMASK
  #undef START
  #undef RESC
  #undef ROT
}
constexpr int ATTN_LDS_BYTES=LDS_BYTES;
template<int THRL=8> __device__ __forceinline__ void attn_phase(char*lds,const bf16*Q,const bf16*K,const bf16*V,bf16*O,const float*KSUM,int vcu,int G,int wave_s){
  for(int p=vcu;p<BATCH*NHEAD*8;p+=G){
    #pragma unroll 1
    for(int k=0;k<2;++k){ const int bh=p>>3,s=p&7,qb=k?s:15-s; attn_unit<THRL>(bh>>3,bh&7,qb,Q,K,V,O,KSUM,lds,wave_s); }
  }
}
#undef SBAR
#undef WAIT_BAR
}

__device__ __forceinline__ float wave_sum(float v, int lane) {
#pragma unroll
    for (int o = 1; o < 64; o <<= 1) v += shx(v, o, lane);
    return v;
}
struct TItem { const float* W; const float* gain; bf16_t* WT; int Ksrc, Nsrc, k0, n0, drow0; };
__device__ __forceinline__ void titem_load(const TItem& d, f32x4 (&v)[8], float (&g)[8], int lane) {
    const int r8 = lane >> 3, c4 = (lane & 7) * 4;
#pragma unroll
    for (int i = 0; i < 8; ++i) { const int kk = 8 * i + r8; v[i] = *(const f32x4*)(d.W + (size_t)(d.k0 + kk) * d.Nsrc + d.n0 + c4); g[i] = d.gain ? d.gain[d.k0 + kk] : 1.0f; }
}
__device__ __forceinline__ void titem_finish(const TItem& d, const f32x4 (&v)[8], const float (&g)[8], LAS float* scr, int lane) {
    const int r8 = lane >> 3, c4 = (lane & 7) * 4;
#pragma unroll
    for (int i = 0; i < 8; ++i) { const int kk = 8 * i + r8; LAS float* p = scr + kk * 33 + c4; p[0] = v[i].x * g[i]; p[1] = v[i].y * g[i]; p[2] = v[i].z * g[i]; p[3] = v[i].w * g[i]; }
    LDS_WAIT(); asm volatile("" ::: "memory");
    const int c = lane & 7;
#pragma unroll
    for (int j = 0; j < 4; ++j) { const int n = (lane >> 3) + 8 * j; const LAS float* s = scr + (8 * c) * 33 + n;
        u32x4 o; o.x = cvt_pk_bf16(s[0 * 33], s[1 * 33]); o.y = cvt_pk_bf16(s[2 * 33], s[3 * 33]); o.z = cvt_pk_bf16(s[4 * 33], s[5 * 33]); o.w = cvt_pk_bf16(s[6 * 33], s[7 * 33]);
        *(u32x4*)(d.WT + (size_t)(d.drow0 + n) * d.Ksrc + d.k0 + 8 * c) = o; }
    LDS_WAIT(); asm volatile("" ::: "memory");
}
__device__ __forceinline__ int win_drow(int c) {
    if (c < 512) return c;
    if (c < 1024) { const int ch = c - 512; return 512 + (ch >> 7) * 256 + (ch & 127); }
    if (c < 1536) { const int ch = c - 1024; return 512 + (ch >> 7) * 256 + 128 + (ch & 127); }
    if (c < 2560) { const int base = c < 2048 ? 1536 : 2048; const int cq = c - base, head = cq >> 6, half = (cq >> 5) & 1; return base + (head >> 2) * 256 + half * 128 + (head & 3) * 32; }
    return c;
}
__device__ __forceinline__ int gu_drow(int c, int isup) { return (c >> 7) * 256 + isup * 128 + (c & 127); }

struct Args { const float* in[21]; float* out; unsigned char* ws; int ph_lo, ph_hi; };

constexpr int TBL_OFF = MISC_OFF + 128;
__device__ __forceinline__ const float* in_ptr(LAS unsigned char* lds, int k) {
    const LAS unsigned* t = (const LAS unsigned*)(lds + TBL_OFF) + 2 * k; unsigned lo = t[0], hi = t[1];
    lo = __builtin_amdgcn_readfirstlane(lo); hi = __builtin_amdgcn_readfirstlane(hi);
    return (const float*)(GAS const float*)(((unsigned long long)hi << 32) | lo);
}
__device__ __forceinline__ unsigned char* launder(unsigned char* p) { size_t z = 0; asm volatile("" : "+s"(z)); return p + z; }

constexpr int I_GU = 16 * 88, I_D = 44 * 32, I_IN = 16 * 160, I_C = 8 * 32, I_O = 16 * 32, I_PP = 4 * 32;
constexpr int ITEMS_L = 6 * I_GU + I_IN + 2 * I_C + 2 * I_O + I_PP;
static_assert(I_GU == I_D && ITEMS_L == 12672, "item counts");

__device__ __forceinline__ TItem p0_decode(LAS unsigned char* lds, bf16_t* Wb, int gi) {
    TItem d; const int L = gi >= ITEMS_L ? 1 : 0; int r = gi - L * ITEMS_L; bf16_t* WL = Wb + (size_t)L * WL_ELEMS; d.gain = nullptr;
    if (r < 4 * I_GU) { const int which = r / I_GU; r -= which * I_GU; const int kb = r / 88, nb = r % 88; const int ffn = which >> 1, isup = which & 1;
        d.W = in_ptr(lds, (ffn ? 11 : 8) + isup) + (size_t)L * DM * FF; d.gain = in_ptr(lds, ffn ? 16 : 14) + L * DM; d.WT = WL + (ffn ? WO_GU2 : WO_GU1);
        d.Ksrc = DM; d.Nsrc = FF; d.k0 = 64 * kb; d.n0 = 32 * nb; d.drow0 = gu_drow(32 * nb, isup); return d; }
    r -= 4 * I_GU;
    if (r < 2 * I_D) { const int ffn = r / I_D; r -= ffn * I_D; const int kb = r / 32, nb = r % 32;
        d.W = in_ptr(lds, ffn ? 13 : 10) + (size_t)L * FF * DM; d.WT = WL + (ffn ? WO_D2 : WO_D1); d.Ksrc = FF; d.Nsrc = DM; d.k0 = 64 * kb; d.n0 = 32 * nb; d.drow0 = 32 * nb; return d; }
    r -= 2 * I_D;
    if (r < I_IN) { const int kb = r / 160, nb = r % 160;
        d.W = in_ptr(lds, 3) + (size_t)L * DM * NIN; d.gain = in_ptr(lds, 15) + L * DM; d.WT = WL + WO_IN; d.Ksrc = DM; d.Nsrc = NIN; d.k0 = 64 * kb; d.n0 = 32 * nb; d.drow0 = win_drow(32 * nb); return d; }
    r -= I_IN;
    if (r < 2 * I_C) { const int which = r / I_C; r -= which * I_C; const int kb = r / 32, nb = r % 32;
        d.W = in_ptr(lds, 5 + which) + (size_t)L * CW * DM; d.WT = WL + (which ? WO_A : WO_C); d.Ksrc = CW; d.Nsrc = DM; d.k0 = 64 * kb; d.n0 = 32 * nb; d.drow0 = 32 * nb; return d; }
    r -= 2 * I_C;
    if (r < 2 * I_O) { const int which = r / I_O; r -= which * I_O; const int kb = r / 32, nb = r % 32;
        d.W = in_ptr(lds, which ? 18 : 7) + (size_t)L * DM * DM; if (which) d.gain = in_ptr(lds, 17) + L * DM; d.WT = WL + (which ? WO_PG : WO_O); d.Ksrc = DM; d.Nsrc = DM; d.k0 = 64 * kb; d.n0 = 32 * nb; d.drow0 = 32 * nb; return d; }
    r -= 2 * I_O;
    { const int kb = r / 32, nb = r % 32;
        d.W = in_ptr(lds, 19) + (size_t)L * PLED * DM; d.WT = WL + WO_PP; d.Ksrc = PLED; d.Nsrc = DM; d.k0 = 64 * kb; d.n0 = 32 * nb; d.drow0 = 32 * nb; return d; }
}
__device__ __forceinline__ void p0_weights(LAS unsigned char* lds, bf16_t* Wb, LAS float* scr, int gw, int NGW, int lane) {
    for (int gi = gw; gi < 2 * ITEMS_L; gi += 2 * NGW) {
        const bool two = gi + NGW < 2 * ITEMS_L;
        const TItem d0 = p0_decode(lds, Wb, gi), d1 = p0_decode(lds, Wb, two ? gi + NGW : gi);
        f32x4 v0[8], v1[8]; float g0[8], g1[8];
        titem_load(d0, v0, g0, lane); if (two) titem_load(d1, v1, g1, lane);
        titem_finish(d0, v0, g0, scr, lane); if (two) titem_finish(d1, v1, g1, scr, lane);
    }
}
__device__ __forceinline__ void p0_rows(const float* x, const int* pos, bf16_t* HB, float* ssq0, float* rcos, float* rsin, int gw, int NGW, int lane) {
    for (int m0 = gw; m0 < M; m0 += 2 * NGW) {
        f32x4 v[2][4];
#pragma unroll
        for (int u = 0; u < 2; ++u) { const int m = (m0 + u * NGW < M) ? m0 + u * NGW : m0; const f32x4* xr = (const f32x4*)(x + (size_t)m * DM) + lane;
#pragma unroll
            for (int j = 0; j < 4; ++j) v[u][j] = xr[64 * j]; }
#pragma unroll
        for (int u = 0; u < 2; ++u) { const int m = m0 + u * NGW; if (m < M) { float s = 0.f;
#pragma unroll
            for (int j = 0; j < 4; ++j) s += (v[u][j].x * v[u][j].x + v[u][j].y * v[u][j].y) + (v[u][j].z * v[u][j].z + v[u][j].w * v[u][j].w);
            s = wave_sum(s, lane);
            u32x2* o8 = (u32x2*)(HB + (size_t)m * DM) + lane;
#pragma unroll
            for (int j = 0; j < 4; ++j) { u32x2 w; w.x = cvt_pk_bf16(v[u][j].x, v[u][j].y); w.y = cvt_pk_bf16(v[u][j].z, v[u][j].w); o8[64 * j] = w; }
            if (lane == 0) *(f32x4*)(ssq0 + 4 * (size_t)m) = (f32x4){s, 0.f, 0.f, 0.f};
            if (lane < 32) { const float p = (float)pos[m]; const float invf = exp2f(-(float)lane * (13.287712379549449f / 32.0f)); const float ang = p * invf; float sn, cs; sincosf(ang, &sn, &cs);
                rcos[(size_t)m * 32 + lane] = cs; rsin[(size_t)m * 32 + lane] = sn; } } }
    }
}
__device__ __forceinline__ void pb_convert(const float* p, bf16_t* PB, int gw, int NGW, int lane) {
    for (int m = gw; m < M; m += NGW) { const f32x4 v = *((const f32x4*)(p + (size_t)m * PLED) + lane); u32x2 w; w.x = pk2(v.x, v.y); w.y = pk2(v.z, v.w); *((u32x2*)(PB + (size_t)m * PLED) + lane) = w; }
}
__device__ __forceinline__ void convmix(const bf16_t* BG, const bf16_t* U, const float* cwt, bf16_t* CM, int gt, int NGT) {
    for (int e = gt; e < M * (CW / 8); e += NGT) { const int r = e >> 6, c8 = (e & 63) * 8, s = r & (SEQ - 1);
        const u32x4 b = *(const u32x4*)(BG + (size_t)r * CW + c8), u0 = *(const u32x4*)(U + (size_t)r * CW + c8);
        u32x4 u1 = (u32x4){0u, 0u, 0u, 0u}, u2 = (u32x4){0u, 0u, 0u, 0u};
        if (s >= 1) u1 = *(const u32x4*)(U + (size_t)(r - 1) * CW + c8);
        if (s >= 2) u2 = *(const u32x4*)(U + (size_t)(r - 2) * CW + c8);
        float o[8];
#pragma unroll
        for (int j = 0; j < 4; ++j) { const unsigned bw = b[j], w0 = u0[j], w1 = u1[j], w2 = u2[j]; const int c = c8 + 2 * j;
            o[2 * j] = bf_lo(bw) * (cwt[c] * bf_lo(w2) + cwt[CW + c] * bf_lo(w1) + cwt[2 * CW + c] * bf_lo(w0));
            o[2 * j + 1] = bf_hi(bw) * (cwt[c + 1] * bf_hi(w2) + cwt[CW + c + 1] * bf_hi(w1) + cwt[2 * CW + c + 1] * bf_hi(w0)); }
        u32x4 w; w.x = pk2(o[0], o[1]); w.y = pk2(o[2], o[3]); w.z = pk2(o[4], o[5]); w.w = pk2(o[6], o[7]);
        *(u32x4*)(CM + (size_t)r * CW + c8) = w; }
}
__device__ __forceinline__ void final_norm(float* h, const float* ssq, const float* g, int gw, int NGW, int lane) {
    for (int m = gw; m < M; m += NGW) { const float rs = rstd_of(ssq, m); f32x4* hr = (f32x4*)(h + (size_t)m * DM) + lane; const f32x4* gr = (const f32x4*)g + lane;
#pragma unroll
        for (int j = 0; j < 4; ++j) { const f32x4 v = hr[64 * j], gg = gr[64 * j]; hr[64 * j] = v * rs * gg; } }
}

#define XB_TMO      128
#define XB_XCNT(j)  (256  + 64 * (j))
#define XB_XSUB(j)  (1280 + 64 * (j))
#define XB_XGEN(j)  (2304 + 64 * (j))
#define XB_TOP      3328
#define XB_TOPGEN   3392
#define XCD_BAR_WORDS 3456
#define XB_SPIN_CAP (1u << 22)
constexpr int CW_BAR = 4096;
__device__ __forceinline__ unsigned xb_ld(unsigned* p)              { return __hip_atomic_load(p, __ATOMIC_RELAXED, __HIP_MEMORY_SCOPE_AGENT); }
__device__ __forceinline__ unsigned xb_add(unsigned* p, unsigned v) { return __hip_atomic_fetch_add(p, v, __ATOMIC_RELAXED, __HIP_MEMORY_SCOPE_AGENT); }
__device__ __forceinline__ unsigned xb_xcc_id() { return (unsigned)__builtin_amdgcn_s_getreg((3 << 11) | 20) & 0xFu; }
#define XB_SPIN(cond, bar) do { unsigned _sp = 0; while (cond) { __builtin_amdgcn_s_sleep(1); \
    if ((++_sp & 255u) == 0u) { if (xb_ld(&(bar)[XB_TMO])) break; if (_sp > XB_SPIN_CAP) { atomicAdd(&(bar)[XB_TMO], 1u); break; } } } } while (0)
__device__ __forceinline__ void xcd_barrier_complete(unsigned* bar, unsigned x, unsigned& nloc, unsigned& nx) {
    const unsigned G = gridDim.x * gridDim.y * gridDim.z;
    unsigned sum, cnt, mine, sp = 0u;
    for (;;) {
        sum = 0u; cnt = 0u; mine = 0u;
#pragma unroll
        for (unsigned j = 0; j < 16; ++j) { const unsigned c = xb_ld(&bar[XB_XCNT(j)]); sum += c; cnt += (c > 0u) ? 1u : 0u; mine = (j == x) ? c : mine; }
        if (sum == G) break;
        __builtin_amdgcn_s_sleep(1);
        if ((++sp & 255u) == 0u) { if (xb_ld(&bar[XB_TMO])) break; if (sp > XB_SPIN_CAP) { atomicAdd(&bar[XB_TMO], 1u); break; } }
    }
    nloc = mine > 0u ? mine : 1u; nx = cnt > 0u ? cnt : 1u;
}
__device__ __forceinline__ void xcd_barrier(unsigned* bar, unsigned x, volatile LAS unsigned* st, bool leader_thread) {
    asm volatile("s_waitcnt vmcnt(0)" ::: "memory");
    __syncthreads();
    if (leader_thread) {
        __builtin_amdgcn_s_waitcnt(0);
        unsigned nloc = st[0], nx = st[1];
        if (nloc == 0u) { xcd_barrier_complete(bar, x, nloc, nx); st[0] = nloc; st[1] = nx; }
        const unsigned old = xb_add(&bar[XB_XSUB(x)], 1u);
        const unsigned gen = old / nloc;
        if (old + 1u == (gen + 1u) * nloc) {
            __builtin_amdgcn_fence(__ATOMIC_RELEASE, "agent");
            asm volatile("s_waitcnt vmcnt(0)" ::: "memory");
            const unsigned og = xb_add(&bar[XB_TOP], 1u);
            const unsigned tg = og / nx;
            if (og + 1u == (tg + 1u) * nx) xb_add(&bar[XB_TOPGEN], 1u);
            else XB_SPIN(xb_ld(&bar[XB_TOPGEN]) == tg, bar);
            __builtin_amdgcn_fence(__ATOMIC_ACQUIRE, "agent");
            xb_add(&bar[XB_XGEN(x)], 1u);
            asm volatile("s_waitcnt vmcnt(0)" ::: "memory");
        } else {
            XB_SPIN(xb_ld(&bar[XB_XGEN(x)]) == gen, bar);
            __builtin_amdgcn_fence(__ATOMIC_ACQUIRE, "agent");
            asm volatile("s_waitcnt vmcnt(0)" ::: "memory");
        }
    }
    __syncthreads();
}

#ifndef REP_J
#define REP_J 99
#endif
#ifndef REP_N
#define REP_N 0
#endif
#ifndef REP_BAR
#define REP_BAR 0
#endif
constexpr int NPHASE = 20;
#ifndef KMASK
#define KMASK 0x3FF
#endif
#define KIND(j) ((KMASK >> (j)) & 1)
__global__ void __launch_bounds__(NWAVES * 64, 2) skel_fwd(Args args) {
    extern __shared__ __attribute__((aligned(16))) unsigned char lds_raw[];
    LAS unsigned char* lds = (LAS unsigned char*)lds_raw;
    const int wave_s = __builtin_amdgcn_readfirstlane(threadIdx.x >> 6);
    {
        const int t0 = threadIdx.x;
        for (int u = t0; u < (LDS_BYTES - LDSCTL_OFF) / 4; u += NWAVES * 64) ((LAS unsigned*)(lds + LDSCTL_OFF))[u] = 0u;
        __syncthreads();
        if (t0 == 0) { LAS unsigned long long* t = (LAS unsigned long long*)(lds + TBL_OFF);
#pragma unroll
            for (int i = 0; i < 21; ++i) t[i] = (unsigned long long)args.in[i]; }
        __syncthreads();
    }
#if MK_ONE_LAUNCH
    const unsigned xcc = xb_xcc_id();
    if (threadIdx.x == 0) (void)xb_add((unsigned*)(args.ws + WS_CTL) + CW_BAR + XB_XCNT(xcc), 1u);
#endif
    for (int ph = args.ph_lo, rep_left = REP_N; ph < args.ph_hi; ) {
        unsigned char* ws = launder(args.ws);
        int bx_ = blockIdx.x, G_ = gridDim.x; asm volatile("" : "+s"(bx_), "+s"(G_));
        const int G = G_, bx = bx_, vcu = (G % 8 == 0) ? (bx % 8) * (G / 8) + bx / 8 : bx, NGW = G * NWAVES;
        const int wave = wave_s, gw = vcu * NWAVES + wave;
#define TID_LANE const int tid = tid_now(wave_s), lane = tid & 63
        const int L = (ph - 1) / 9, j = (ph == 0) ? -1 : (ph == NPHASE - 1) ? 9 : (ph - 1) % 9;
        bf16_t* HB = (bf16_t*)(ws + WS_HB); unsigned char* X = ws + WS_X;
        const bf16_t* WL = (const bf16_t*)(ws + WS_W) + (size_t)L * WL_ELEMS;
        float *ssq0 = (float*)(ws + WS_SSQ0), *ssq1 = (float*)(ws + WS_SSQ1);
        const bool dummy = (REP_N > 0) && (j == REP_J) && (rep_left > 0);
        if (KIND(0) && j == -1) { TID_LANE;
            p0_weights(lds, (bf16_t*)(ws + WS_W), (LAS float*)(lds + wave * 16384), gw, NGW, lane);
            p0_rows(in_ptr(lds, 0), (const int*)in_ptr(lds, 2), HB, ssq0, (float*)(ws + WS_COS), (float*)(ws + WS_SIN), gw, NGW, lane);
        } else if (KIND(1) && (j == 0 || j == 6)) {
            pg8::Gemm g{HB, WL + (j ? WO_GU2 : WO_GU1), nullptr, nullptr, DM}; pg8::StaticOrder S; S.init(M, NGU, G, bx);
            pg8::EpiSwiglu E{(bf16_t*)(X + X_ACT), ssq0};
            pg8::gemm_phase<pg8::EpiSwiglu, pg8::StaticOrder, true>(lds, g, S, E, wave_s);
            if (j == 6 && G == 256 && bx >= 128) {
                pg8::Gemm g2{(const bf16_t*)(X + X_PB), WL + WO_PP, nullptr, nullptr, PLED}; pg8::StaticOrder S2; S2.init(M, DM, 128, bx - 128);
                pg8::EpiPlain E2{(bf16_t*)(X + X_T2), DM};
                pg8::gemm_phase<pg8::EpiPlain, pg8::StaticOrder, true>(lds, g2, S2, E2, wave_s); }
        } else if (KIND(2) && (j == 1 || j == 7)) {
            const float* hin = (ph == 2) ? in_ptr(lds, 0) : args.out;
            { pg8::Gemm g{(const bf16_t*)(X + X_ACT), WL + (j == 7 ? WO_D2 : WO_D1), nullptr, nullptr, FF}; pg8::StaticOrder S; S.init(M, DM, G, bx);
              pg8::EpiRes<0> E{hin, args.out, HB, ssq1, dummy ? 0.0f : 0.5f, nullptr, nullptr};
              pg8::gemm_phase<pg8::EpiRes<0>, pg8::StaticOrder, false>(lds, g, S, E, wave_s); }
            if (j == 7 && G != 256) { pg8::Gemm g2{(const bf16_t*)(X + X_PB), WL + WO_PP, nullptr, nullptr, PLED}; pg8::StaticOrder S2; S2.init(M, DM, G, bx);
              pg8::EpiPlain E2{(bf16_t*)(X + X_T2), DM};
              pg8::gemm_phase<pg8::EpiPlain, pg8::StaticOrder, true>(lds, g2, S2, E2, wave_s); }
        } else if (KIND(3) && j == 2) {
            pg8::Gemm g{HB, WL + WO_IN, nullptr, nullptr, DM}; pg8::StaticOrder S; S.init(M, NIN, G, bx);
            pg8::EpiWin E{ws, ssq1};
            pg8::gemm_phase<pg8::EpiWin, pg8::StaticOrder, true>(lds, g, S, E, wave_s);
        } else if (KIND(4) && j == 3) { TID_LANE;
            bf16_t* Qb = (bf16_t*)(X + X_Q);
            moba::attn_phase<8>((char*)lds_raw, (const moba::bf16*)Qb, (const moba::bf16*)(X + X_K), (const moba::bf16*)(X + X_V), (moba::bf16*)(dummy ? HB + (size_t)M * 512 : Qb), (const float*)(ws + WS_KSUM), vcu, G, wave_s);
            convmix((const bf16_t*)(X + X_BG), (const bf16_t*)(X + X_U), in_ptr(lds, 4) + (size_t)L * 3 * CW, HB  , vcu * NWAVES * 64 + tid, NGW * 64);
        } else if (KIND(5) && j == 4) {
            pg8::Gemm g{HB  , WL + WO_C, (const bf16_t*)(X + X_Q)  , WL + WO_A, CW}; pg8::TwoSegOrder S; S.so.init(M, DM, G, bx);
            pg8::EpiMerge E{(const bf16_t*)(X + X_SGC), (const bf16_t*)(X + X_SGA), (bf16_t*)(X + X_MERGED)};
            pg8::gemm_phase<pg8::EpiMerge, pg8::TwoSegOrder, true>(lds, g, S, E, wave_s);
        } else if (KIND(6) && j == 5) {
            { pg8::Gemm g{(const bf16_t*)(X + X_MERGED), WL + WO_O, nullptr, nullptr, DM}; pg8::StaticOrder S; S.init(M, DM, G, bx);
              pg8::EpiRes<0> E{args.out, args.out, HB, ssq0, dummy ? 0.0f : 1.0f, nullptr, nullptr};
              pg8::gemm_phase<pg8::EpiRes<0>, pg8::StaticOrder, false>(lds, g, S, E, wave_s); }
            TID_LANE; pb_convert(in_ptr(lds, 1) + (size_t)L * M * PLED, (bf16_t*)(X + X_PB), gw, NGW, lane);
        } else if (KIND(7) && j == 8) {
            pg8::Gemm g{HB, WL + WO_PG, nullptr, nullptr, DM}; pg8::StaticOrder S; S.init(M, DM, G, bx);
            pg8::EpiRes<1> E{args.out, args.out, HB, ssq0, dummy ? 0.0f : 1.0f, ssq1, (const bf16_t*)(X + X_T2)};
            pg8::gemm_phase<pg8::EpiRes<1>, pg8::StaticOrder, false>(lds, g, S, E, wave_s);
        } else if (KIND(8) && j == 9) { TID_LANE;
            final_norm(args.out, ssq0, in_ptr(lds, 20), gw, NGW, lane);
        }
#if MK_ONE_LAUNCH
        if (ph + 1 < args.ph_hi) {
            if (args.ph_lo < 0) cooperative_groups::this_grid().sync();
            { for (int rb = 0; rb <= REP_BAR; ++rb) { const int tb = tid_now(wave_s); xcd_barrier((unsigned*)(args.ws + WS_CTL) + CW_BAR, xcc, (volatile LAS unsigned*)(lds + MISC_OFF) + 8, tb == 0); } }
        }
#endif
        if (dummy) --rep_left; else { ++ph; rep_left = REP_N; }
    }
}

extern "C" void kernel_launch(void* const* d_in, const int* in_sizes, int n_in, void* d_out, int out_size, void* d_ws, size_t ws_size, hipStream_t stream) {
    static int grid = 0;
    if (grid == 0) {
        if (n_in != 21 || in_sizes[0] != M * DM || out_size != M * DM || ws_size < WS_END) { fprintf(stderr, "kernel_launch: unexpected shapes / workspace (%d inputs, ws %zu)\n", n_in, ws_size); grid = -1; return; }
        int dev = 0, cus = 0;
        if (hipGetDevice(&dev) != hipSuccess || hipDeviceGetAttribute(&cus, hipDeviceAttributeMultiprocessorCount, dev) != hipSuccess) { grid = -1; return; }
        if (hipFuncSetAttribute((const void*)skel_fwd, hipFuncAttributeMaxDynamicSharedMemorySize, LDS_BYTES) != hipSuccess) { fprintf(stderr, "kernel_launch: hipFuncSetAttribute failed\n"); grid = -1; return; }
        (void)hipGetLastError();
        grid = 256;
        if (cus != 256) fprintf(stderr, "kernel_launch: device has %d CUs; this kernel is built for 256\n", cus);
    }
    if (grid < 0) return;
    (void)hipMemsetAsync((char*)d_ws + WS_CTL, 0, CTL_ZERO_BYTES, stream);
    Args a{};
    for (int i = 0; i < 21; ++i) a.in[i] = (const float*)d_in[i];
    a.out = (float*)d_out; a.ws = (unsigned char*)d_ws;
#if MK_ONE_LAUNCH
    a.ph_lo = 0; a.ph_hi = NPHASE;
    void* kargs[] = {&a};
    const hipError_t e = hipLaunchCooperativeKernel((const void*)skel_fwd, dim3(grid), dim3(NWAVES * 64), kargs, LDS_BYTES, stream);
    if (e != hipSuccess) fprintf(stderr, "kernel_launch: cooperative launch failed: %s\n", hipGetErrorString(e));
#else
    for (int ph = 0; ph < NPHASE; ++ph) {
        a.ph_lo = ph; a.ph_hi = ph + 1;
        hipLaunchKernelGGL(skel_fwd, dim3(grid), dim3(NWAVES * 64), LDS_BYTES, stream, a);
    }
#endif
}
```
